# Optimizing an MI355X kernel written in HIP

```python
import math
import jax, jax.numpy as jnp
from jax import lax
import numpy as np

D_MODEL = 2048
BATCH = 1
SEQ = 16384
DEPTH = 1

A_HEADS = 8
A_QK_DIM = 64
A_V_DIM = 2 * A_QK_DIM
A_SCALE = A_QK_DIM ** -0.5
B_HEADS = 8
B_NOPE_DIM = 128
B_ROPE_DIM = 64
B_V_DIM = 128
Q_LORA_RANK = 512
KV_LORA_RANK = 256
B_SCALE = (B_NOPE_DIM + B_ROPE_DIM) ** -0.5
ROPE_THETA = 10000.0
A_QK_COLS = A_HEADS * 2 * A_QK_DIM
A_V_COLS = A_HEADS * A_V_DIM
MIX_WIDTH = A_HEADS * A_V_DIM + B_HEADS * B_V_DIM
IN_SIZES = (A_QK_COLS, A_QK_COLS, A_V_COLS, Q_LORA_RANK, KV_LORA_RANK, B_ROPE_DIM)
IN_COLS = sum(IN_SIZES)
IN_SPLITS = tuple(int(v) for v in np.cumsum(IN_SIZES)[:-1])
NUM_BUCKETS = 32
MAX_DISTANCE = 128
D_FF = -(-8 * D_MODEL // (3 * 256)) * 256
BLOCK_Q = 128
EPS = 1e-6

kernel_name = "hybrid_diffattn_mla_encoder_layer"


def lambda_init_fn(layer_idx):
    return 0.8 - 0.6 * math.exp(-0.3 * layer_idx)


def rms_norm(x, g):
    xf = x.astype(jnp.float32)
    y = xf * lax.rsqrt(jnp.mean(xf * xf, axis=-1, keepdims=True) + EPS)
    return (y * g.astype(jnp.float32)).astype(x.dtype)


def rope_tables(pos):
    half = B_ROPE_DIM // 2
    inv = ROPE_THETA ** (-jnp.arange(half, dtype=jnp.float32) / half)
    ang = pos.astype(jnp.float32)[:, None] * inv[None, :]
    return jnp.cos(ang), jnp.sin(ang)


def apply_rope(t, cos, sin):
    half = t.shape[-1] // 2
    tf = t.astype(jnp.float32)
    t1, t2 = tf[..., :half], tf[..., half:]
    return jnp.concatenate([t1 * cos - t2 * sin, t2 * cos + t1 * sin], axis=-1).astype(t.dtype)


def t5_bucket(rel):
    nb = NUM_BUCKETS // 2
    max_exact = nb // 2
    side = jnp.where(rel > 0, nb, 0)
    n = jnp.abs(rel)
    n_f = jnp.maximum(n, 1).astype(jnp.float32)
    large = max_exact + (jnp.log(n_f / max_exact) / math.log(MAX_DISTANCE / max_exact)
                         * (nb - max_exact)).astype(jnp.int32)
    large = jnp.minimum(large, nb - 1)
    return side + jnp.where(n < max_exact, n, large)


def hybrid_mixer(h, pos, cos, sin, w_in, q_norm_g, w_uq, kv_norm_g, w_ukv,
                 lambda_q1, lambda_k1, lambda_q2, lambda_k2, subln_g, rel_bias, lambda_init):
    B, S, _ = h.shape
    proj = jnp.einsum('bsd,dc->bsc', h, w_in)
    qa, ka, va, cq, ckv, kr = jnp.split(proj, IN_SPLITS, axis=-1)
    qa = qa.reshape(B, S, A_HEADS, 2, A_QK_DIM)
    ka = ka.reshape(B, S, A_HEADS, 2, A_QK_DIM)
    va = va.reshape(B, S, A_HEADS, A_V_DIM)
    lam = (jnp.exp(jnp.sum(lambda_q1.astype(jnp.float32) * lambda_k1.astype(jnp.float32)))
           - jnp.exp(jnp.sum(lambda_q2.astype(jnp.float32) * lambda_k2.astype(jnp.float32)))
           + lambda_init)
    qb = jnp.einsum('bsr,rc->bsc', rms_norm(cq, q_norm_g), w_uq)
    qb = qb.reshape(B, S, B_HEADS, B_NOPE_DIM + B_ROPE_DIM)
    qb_nope = qb[..., :B_NOPE_DIM]
    qb_rope = apply_rope(qb[..., B_NOPE_DIM:], cos[:, None, :], sin[:, None, :])
    kv = jnp.einsum('bsr,rc->bsc', rms_norm(ckv, kv_norm_g), w_ukv)
    kv = kv.reshape(B, S, B_HEADS, B_NOPE_DIM + B_V_DIM)
    kb_nope, vb = kv[..., :B_NOPE_DIM], kv[..., B_NOPE_DIM:]
    kb_rope = apply_rope(kr, cos, sin)

    n_blk = S // BLOCK_Q

    def to_blocks(t):
        return t.reshape((B, n_blk, BLOCK_Q) + t.shape[2:]).swapaxes(0, 1)

    def block_fn(args):
        qa_b, qn_b, qr_b, qpos = args
        rel = pos[None, :] - qpos[:, None]
        bias = jnp.transpose(rel_bias[t5_bucket(rel)], (2, 0, 1)).astype(jnp.float32)
        s_a = jnp.einsum('bqhmd,bkhmd->bhmqk', qa_b, ka).astype(jnp.float32) * A_SCALE
        p_a = jax.nn.softmax(s_a + bias[None, :, None], axis=-1)
        w_a = p_a[:, :, 0] - lam * p_a[:, :, 1]
        o_a = jnp.einsum('bhqk,bkhd->bqhd', w_a.astype(va.dtype), va)
        s_b = (jnp.einsum('bqhd,bkhd->bhqk', qn_b, kb_nope)
               + jnp.einsum('bqhr,bkr->bhqk', qr_b, kb_rope)).astype(jnp.float32) * B_SCALE
        p_b = jax.nn.softmax(s_b, axis=-1)
        o_b = jnp.einsum('bhqk,bkhd->bqhd', p_b.astype(vb.dtype), vb)
        return o_a, o_b

    o_a, o_b = lax.map(block_fn, (to_blocks(qa), to_blocks(qb_nope), to_blocks(qb_rope),
                                  pos.reshape(n_blk, BLOCK_Q)))
    o_a = o_a.swapaxes(0, 1).reshape(B, S, A_HEADS, A_V_DIM)
    o_b = o_b.swapaxes(0, 1).reshape(B, S, B_HEADS * B_V_DIM)
    o_a = rms_norm(o_a, subln_g) * (1.0 - lambda_init)
    return jnp.concatenate([o_a.reshape(B, S, A_HEADS * A_V_DIM), o_b], axis=-1)


def swiglu(h, w_gate, w_up, w_down):
    g = jnp.einsum('bsd,df->bsf', h, w_gate)
    u = jnp.einsum('bsd,df->bsf', h, w_up)
    return jnp.einsum('bsf,fd->bsd', jax.nn.silu(g) * u, w_down)


def setup_inputs(seed: int = 0) -> dict:
    key = jax.random.key(seed)
    ks = jax.random.split(key, 20)
    f = jnp.float32

    def nrm(k, shape, scale):
        return jax.random.normal(k, shape, f) * scale

    def gain(k, shape):
        return 1.0 + 0.02 * jax.random.normal(k, shape, f)

    L = DEPTH
    return {
        "x": jax.random.normal(ks[0], (BATCH, SEQ, D_MODEL), f),
        "ln1_g": gain(ks[1], (L, D_MODEL)),
        "w_in": nrm(ks[2], (L, D_MODEL, IN_COLS), D_MODEL ** -0.5),
        "q_norm_g": gain(ks[3], (L, Q_LORA_RANK)),
        "w_uq": nrm(ks[4], (L, Q_LORA_RANK, B_HEADS * (B_NOPE_DIM + B_ROPE_DIM)), Q_LORA_RANK ** -0.5),
        "kv_norm_g": gain(ks[5], (L, KV_LORA_RANK)),
        "w_ukv": nrm(ks[6], (L, KV_LORA_RANK, B_HEADS * (B_NOPE_DIM + B_V_DIM)), KV_LORA_RANK ** -0.5),
        "lambda_q1": nrm(ks[7], (L, A_QK_DIM), 0.1),
        "lambda_k1": nrm(ks[8], (L, A_QK_DIM), 0.1),
        "lambda_q2": nrm(ks[9], (L, A_QK_DIM), 0.1),
        "lambda_k2": nrm(ks[10], (L, A_QK_DIM), 0.1),
        "subln_g": gain(ks[11], (L, A_V_DIM)),
        "rel_bias": nrm(ks[12], (NUM_BUCKETS, A_HEADS), 0.5),
        "w_out": nrm(ks[13], (L, MIX_WIDTH, D_MODEL), MIX_WIDTH ** -0.5),
        "ln2_g": gain(ks[14], (L, D_MODEL)),
        "w_gate": nrm(ks[15], (L, D_MODEL, D_FF), D_MODEL ** -0.5),
        "w_up": nrm(ks[16], (L, D_MODEL, D_FF), D_MODEL ** -0.5),
        "w_down": nrm(ks[17], (L, D_FF, D_MODEL), D_FF ** -0.5),
        "lnf_g": gain(ks[18], (D_MODEL,)),
    }


def reference(x, ln1_g, w_in, q_norm_g, w_uq, kv_norm_g, w_ukv, lambda_q1, lambda_k1,
              lambda_q2, lambda_k2, subln_g, rel_bias, w_out, ln2_g, w_gate, w_up, w_down, lnf_g):
    S = x.shape[1]
    pos = jnp.arange(S, dtype=jnp.int32)
    cos, sin = rope_tables(pos)
    for l in range(DEPTH):
        h = rms_norm(x, ln1_g[l])
        mix = hybrid_mixer(h, pos, cos, sin, w_in[l], q_norm_g[l], w_uq[l], kv_norm_g[l], w_ukv[l],
                           lambda_q1[l], lambda_k1[l], lambda_q2[l], lambda_k2[l], subln_g[l],
                           rel_bias, lambda_init_fn(l))
        x = x + jnp.einsum('bsc,cd->bsd', mix, w_out[l])
        h = rms_norm(x, ln2_g[l])
        x = x + swiglu(h, w_gate[l], w_up[l], w_down[l])
    return rms_norm(x, lnf_g)
```

```cpp
#define NO_SBAR 1
#include <hip/hip_runtime.h>
#include <hip/hip_cooperative_groups.h>
#include <cstdio>
#include <cstdint>
namespace cg = cooperative_groups;

#ifndef MK_N_LAUNCHES
#define MK_N_LAUNCHES 1
#endif

#define LAS __attribute__((address_space(3)))
typedef unsigned short bf16_t;
typedef short bf16x8 __attribute__((ext_vector_type(8)));
typedef short s16x4 __attribute__((ext_vector_type(4)));
typedef float f32x4 __attribute__((ext_vector_type(4)));
typedef float f32x2 __attribute__((ext_vector_type(2)));
typedef float f32x16 __attribute__((ext_vector_type(16)));
typedef unsigned u32x4 __attribute__((ext_vector_type(4)));
typedef unsigned u32x2 __attribute__((ext_vector_type(2)));

constexpr int S = 16384, DM = 2048, NIN = 3904, NINP = 4096, DFF = 5632, NGU = 2 * DFF;
constexpr int QLR = 512, KVLR = 256, NQB = 1536, NKV = 2048;
constexpr float EPS = 1e-6f, LOG2E = 1.4426950408889634f;
constexpr int NPHASE = 9;

constexpr size_t MiB = 1u << 20;
constexpr size_t WS_CTL = 0;
constexpr size_t WS_TBL = 4096, WS_SSQQ = 65536, WS_SSQKV = 131072, WS_KMXA = 256, WS_KMXB = 384, WS_TBLMAX = 512, WS_KMXR = 640, WS_SSQ2 = 196608;
constexpr size_t WS_COS = 1 * MiB, WS_SIN = 3 * MiB;
constexpr size_t WS_WUQ = 5 * MiB, WS_WUKV = 7 * MiB, WS_WIN = 8 * MiB, WS_WOUT = 24 * MiB, WS_WGU = 32 * MiB, WS_WDN = 76 * MiB;
constexpr size_t WS_HB = 98 * MiB;
constexpr size_t WS_X1 = 162 * MiB;
constexpr size_t WS_O1 = WS_X1, WS_CQ = WS_X1 + 64 * MiB, WS_CKV = WS_X1 + 80 * MiB, WS_VB = WS_X1 + 88 * MiB;
constexpr size_t WS_R = 290 * MiB;
constexpr size_t WS_QA = WS_R, WS_KA = WS_R + 32 * MiB, WS_VA = WS_R + 64 * MiB, WS_QB = WS_R + 96 * MiB, WS_KB = WS_R + 144 * MiB;
constexpr size_t WS_ACT = WS_R;
constexpr size_t WS_END = WS_R + 192 * MiB;

__device__ __forceinline__ unsigned cvt_pk_bf16(float lo, float hi) { unsigned r; asm volatile("v_cvt_pk_bf16_f32 %0, %1, %2" : "=v"(r) : "v"(lo), "v"(hi)); return r; }
__device__ __forceinline__ float wave_sum(float v) {
#pragma unroll
    for (int o = 1; o < 64; o <<= 1) v += __shfl_xor(v, o);
    return v;
}
#define LDS_WAIT() asm volatile("s_waitcnt lgkmcnt(0)" ::: "memory")

namespace pg8 {
constexpr int BM = 256, BK = 64, HALF = 128, HTB = HALF * BK * 2, STAGE_BYTES = 8 * HTB, NXCD = 8, WGM = 8;
__host__ __device__ __forceinline__ int lds_byte(int r, int c) { const int st = (r >> 4) * 2 + (c >> 5), rr = r & 15, cc = c & 31, ob = rr * 64 + cc * 2; return st * 1024 + (ob ^ (((ob >> 9) & 1) << 5)); }
__host__ __device__ __forceinline__ void stage_rc(int b, int& R, int& C) { const int st = b / 1024, sb = b % 1024, swz = sb ^ (((sb >> 9) & 1) << 5); R = (st >> 1) * 16 + swz / 64; C = (st & 1) * 32 + (swz % 64) / 2; }
__host__ __device__ __forceinline__ int perm32(int rho) { const int n = rho >> 4, i = rho & 15; return 8 * (i >> 2) + 4 * n + (i & 3); }
struct Unit { int pm, pn; };
struct Gemm { const bf16_t* A; const bf16_t* Bt; int M, N, K; };
struct StaticOrder {
    int nM, nN, nwg, G, c;
    __host__ __device__ void init(int M, int N, int G_, int c_) { nM = M / BM; nN = N / BM; nwg = nM * nN; G = G_; c = c_; }
    __host__ __device__ bool next(int i, Unit& u) const {
        const long L = (long)i * G + c; if (L >= nwg) return false;
        int wgid = (int)L; { const int q = nwg / NXCD, r = nwg % NXCD, xcd = wgid % NXCD, off = wgid / NXCD; wgid = (xcd < r ? xcd * (q + 1) : r * (q + 1) + (xcd - r) * q) + off; }
        const int nig = WGM * nN, gid = wgid / nig, fm = gid * WGM, gsz = (nM - fm) < WGM ? (nM - fm) : WGM;
        u.pm = fm + ((wgid % nig) % gsz); u.pn = (wgid % nig) / gsz; return true;
    }
    __device__ __forceinline__ void a_ready(const Unit&) const {}
    __device__ __forceinline__ void done(const Unit&) const {}
};
template <class Epi, class Sched, bool ALIGN_EPI = false, bool SP2 = false>
__device__ __forceinline__ void gemm_phase(LAS unsigned char* lds, const Gemm g, const Sched& Sd, const Epi& E) {
    int tid_ = threadIdx.x; asm volatile("" : "+v"(tid_));
    const int tid = tid_, wid = __builtin_amdgcn_readfirstlane(tid >> 6), lane = tid & 63, wr = wid >> 2, wc = wid & 3, fr = lane & 15, fq = lane >> 4;
    const int K = g.K, nt = K / BK;
    unsigned voffA[2], voffB[2];
#pragma unroll
    for (int i = 0; i < 2; ++i) { int R, C; stage_rc(tid * 16 + i * 8192, R, C); const int Rb = Epi::PERM ? ((R & ~31) + perm32(R & 31)) : R;
        voffA[i] = (unsigned)(R * K + C) * 2u; voffB[i] = (unsigned)(Rb * K + C) * 2u; }
    const size_t kstep = (size_t)(BK * 2);
    const size_t hstep = (size_t)HALF * K * 2;
    const size_t tstep = 2 * hstep;
    const unsigned ldsw = (unsigned)wid * 1024u;
    const int aoff = lds_byte(wr * 64 + fr, fq * 8), boff = lds_byte(wc * 32 + fr, fq * 8);
#define PG8_SA(b, h) (((b) * 2 + (h)) * HTB)
#define PG8_SB(b, h) ((4 + (b) * 2 + (h)) * HTB)
#define PG8_STAGE(bufoff, gbase, voff) do { _Pragma("unroll") for (int _i = 0; _i < 2; ++_i) \
        __builtin_amdgcn_global_load_lds((const unsigned*)((const char*)(gbase) + (voff)[_i]), (LAS unsigned*)(lds + (bufoff) + ldsw + _i * 8192), 16, 0, 0); } while (0)
#define PG8_LDA(dst, b, h) do { _Pragma("unroll") for (int m = 0; m < 4; ++m) _Pragma("unroll") for (int k = 0; k < 2; ++k) dst[m][k] = *(const LAS bf16x8*)(lds + PG8_SA(b, h) + aoff + m * 2048 + k * 1024); } while (0)
#define PG8_LDB(dst, b, h) do { _Pragma("unroll") for (int n = 0; n < 2; ++n) _Pragma("unroll") for (int k = 0; k < 2; ++k) dst[n][k] = *(const LAS bf16x8*)(lds + PG8_SB(b, h) + boff + n * 2048 + k * 1024); } while (0)
#define PG8_MMA(ai, bj, At, Bt) do { __builtin_amdgcn_s_setprio(1); _Pragma("unroll") for (int m = 0; m < 4; ++m) _Pragma("unroll") for (int n = 0; n < 2; ++n) _Pragma("unroll") for (int k = 0; k < 2; ++k) \
        acc[ai][bj][m][n] = __builtin_amdgcn_mfma_f32_16x16x32_bf16(Bt[n][k], At[m][k], acc[ai][bj][m][n], 0, 0, 0); __builtin_amdgcn_s_setprio(0); } while (0)
#define PG8_WAIT_V(n) asm volatile("s_waitcnt vmcnt(" #n ")" ::: "memory")
#define PG8_WAIT_L(n) asm volatile("s_waitcnt lgkmcnt(" #n ")" ::: "memory")
#define PG8_BAR __builtin_amdgcn_s_barrier()
#define PG8_SCHED __builtin_amdgcn_sched_barrier(0)
    Unit cur, nxt; int ui = 0;
    if (!Sd.next(0, cur)) return;
    f32x4 acc[2][2][4][2];
#pragma unroll
    for (int a = 0; a < 2; ++a)
#pragma unroll
        for (int b = 0; b < 2; ++b)
#pragma unroll
            for (int m = 0; m < 4; ++m)
#pragma unroll
                for (int n = 0; n < 2; ++n) acc[a][b][m][n] = (f32x4){0.f, 0.f, 0.f, 0.f};
    bf16x8 At[4][2], B0[2][2], B1[2][2];
    const char* cA = (const char*)g.A + (size_t)cur.pm * tstep; const char* cB = (const char*)g.Bt + (size_t)cur.pn * tstep;
    Sd.a_ready(cur);
    if constexpr (SP2) {
        PG8_STAGE(PG8_SB(0, 0), cB, voffB); PG8_STAGE(PG8_SB(0, 1), cB + hstep, voffB); PG8_STAGE(PG8_SA(0, 0), cA, voffA); PG8_STAGE(PG8_SA(0, 1), cA + hstep, voffA);
        if (wr == 1) PG8_BAR;
        PG8_WAIT_V(2); PG8_BAR;
        PG8_STAGE(PG8_SB(1, 0), cB + kstep, voffB); PG8_STAGE(PG8_SA(1, 0), cA + kstep, voffA); PG8_STAGE(PG8_SB(1, 1), cB + hstep + kstep, voffB);
        PG8_WAIT_V(6); PG8_BAR;
    } else {
        PG8_STAGE(PG8_SB(0, 0), cB, voffB); PG8_STAGE(PG8_SA(0, 0), cA, voffA); PG8_STAGE(PG8_SB(0, 1), cB + hstep, voffB); PG8_STAGE(PG8_SA(0, 1), cA + hstep, voffA);
        if (wr == 1) PG8_BAR;
        PG8_WAIT_V(4); PG8_BAR;
        PG8_STAGE(PG8_SB(1, 0), cB + kstep, voffB); PG8_STAGE(PG8_SA(1, 0), cA + kstep, voffA); PG8_STAGE(PG8_SB(1, 1), cB + hstep + kstep, voffB);
        PG8_WAIT_V(6); PG8_BAR;
    }
    for (;;) {
        const bool has_next = Sd.next(ui + 1, nxt);
        const char* nA = has_next ? (const char*)g.A + (size_t)nxt.pm * tstep : cA; const char* nB = has_next ? (const char*)g.Bt + (size_t)nxt.pn * tstep : cB;
        for (int t = 0; t < nt; t += 2) {
            const bool last = (t == nt - 2);
            const char* a1 = cA + (size_t)(t + 1) * kstep;
            const char* a2 = last ? nA : cA + (size_t)(t + 2) * kstep; const char* b2 = last ? nB : cB + (size_t)(t + 2) * kstep;
            const char* a3 = a2 + kstep; const char* b3 = b2 + kstep;
            if (last && has_next) Sd.a_ready(nxt);
            if constexpr (SP2) {
            PG8_LDB(B0, 0, 0); PG8_LDB(B1, 0, 1); PG8_SCHED; PG8_LDA(At, 0, 0); PG8_STAGE(PG8_SA(1, 1), a1 + hstep, voffA);
            PG8_WAIT_V(8); PG8_WAIT_L(0); PG8_BAR; PG8_MMA(0, 0, At, B0); PG8_MMA(0, 1, At, B1); PG8_BAR; PG8_SCHED;
            PG8_LDA(At, 0, 1); PG8_STAGE(PG8_SB(0, 0), b2, voffB); PG8_STAGE(PG8_SB(0, 1), b2 + hstep, voffB); PG8_STAGE(PG8_SA(0, 0), a2, voffA);
            PG8_WAIT_V(8); PG8_WAIT_L(0); PG8_BAR; PG8_MMA(1, 0, At, B0); PG8_MMA(1, 1, At, B1); PG8_BAR; PG8_SCHED;
            PG8_LDB(B0, 1, 0); PG8_LDB(B1, 1, 1); PG8_SCHED; PG8_LDA(At, 1, 0); PG8_STAGE(PG8_SA(0, 1), a2 + hstep, voffA);
            PG8_WAIT_V(8); PG8_WAIT_L(0); PG8_BAR; PG8_MMA(0, 0, At, B0); PG8_MMA(0, 1, At, B1); PG8_BAR; PG8_SCHED;
            PG8_LDA(At, 1, 1); PG8_STAGE(PG8_SB(1, 0), b3, voffB); PG8_STAGE(PG8_SB(1, 1), b3 + hstep, voffB); PG8_STAGE(PG8_SA(1, 0), a3, voffA);
            PG8_WAIT_V(8); PG8_WAIT_L(0); PG8_BAR; PG8_MMA(1, 0, At, B0); PG8_MMA(1, 1, At, B1); PG8_BAR; PG8_SCHED;
            } else {
            PG8_LDB(B0, 0, 0); PG8_SCHED; PG8_LDA(At, 0, 0); PG8_STAGE(PG8_SA(1, 1), a1 + hstep, voffA);
            PG8_WAIT_L(8); PG8_BAR; PG8_WAIT_L(0); PG8_MMA(0, 0, At, B0); PG8_BAR; PG8_SCHED;
            PG8_LDB(B1, 0, 1); PG8_STAGE(PG8_SB(0, 0), b2, voffB);
            PG8_BAR; PG8_WAIT_L(0); PG8_MMA(0, 1, At, B1); PG8_BAR;
            PG8_LDA(At, 0, 1); PG8_STAGE(PG8_SA(0, 0), a2, voffA);
            PG8_BAR; PG8_WAIT_L(0); PG8_MMA(1, 0, At, B0); PG8_BAR; PG8_SCHED;
            PG8_STAGE(PG8_SB(0, 1), b2 + hstep, voffB);
            PG8_WAIT_V(6); PG8_BAR; PG8_MMA(1, 1, At, B1); PG8_BAR;
            PG8_LDB(B0, 1, 0); PG8_SCHED; PG8_LDA(At, 1, 0); PG8_STAGE(PG8_SA(0, 1), a2 + hstep, voffA);
            PG8_WAIT_L(8); PG8_BAR; PG8_WAIT_L(0); PG8_MMA(0, 0, At, B0); PG8_BAR; PG8_SCHED;
            PG8_LDB(B1, 1, 1); PG8_STAGE(PG8_SB(1, 0), b3, voffB);
            PG8_BAR; PG8_WAIT_L(0); PG8_MMA(0, 1, At, B1); PG8_BAR;
            PG8_LDA(At, 1, 1); PG8_STAGE(PG8_SA(1, 0), a3, voffA);
            PG8_BAR; PG8_WAIT_L(0); PG8_MMA(1, 0, At, B0); PG8_BAR; PG8_SCHED;
            PG8_STAGE(PG8_SB(1, 1), b3 + hstep, voffB);
            PG8_WAIT_V(6); PG8_BAR; PG8_MMA(1, 1, At, B1); PG8_BAR;
            }
        }
        if constexpr (ALIGN_EPI) { if (wr == 0) PG8_BAR; }
        E(acc, cur, wr, wc, fr, fq); Sd.done(cur);
        if (!has_next) break;
#pragma unroll
        for (int a = 0; a < 2; ++a)
#pragma unroll
            for (int b = 0; b < 2; ++b)
#pragma unroll
                for (int m = 0; m < 4; ++m)
#pragma unroll
                    for (int n = 0; n < 2; ++n) acc[a][b][m][n] = (f32x4){0.f, 0.f, 0.f, 0.f};
        cur = nxt; cA = nA; cB = nB; ++ui;
        if constexpr (ALIGN_EPI) { if (wr == 1) PG8_BAR; }
    }
    PG8_WAIT_V(0);
    if constexpr (!ALIGN_EPI) { if (wr == 0) PG8_BAR; }
    PG8_BAR;
#undef PG8_SA
#undef PG8_SB
#undef PG8_STAGE
#undef PG8_LDA
#undef PG8_LDB
#undef PG8_MMA
#undef PG8_WAIT_V
#undef PG8_WAIT_L
#undef PG8_BAR
#undef PG8_SCHED
}
}

using pg8::Unit;
__device__ __forceinline__ u32x4 pack8(f32x4 a, f32x4 b) { u32x4 w; w.x = cvt_pk_bf16(a[0], a[1]); w.y = cvt_pk_bf16(a[2], a[3]); w.z = cvt_pk_bf16(b[0], b[1]); w.w = cvt_pk_bf16(b[2], b[3]); return w; }
__device__ __forceinline__ void rope8(f32x4& v0, f32x4& v1, f32x4 cs, f32x4 sn) {
    f32x4 a = v0, b = v1;
    v0[0] = a[0] * cs[0] - a[1] * sn[0]; v0[1] = a[1] * cs[0] + a[0] * sn[0];
    v0[2] = a[2] * cs[1] - a[3] * sn[1]; v0[3] = a[3] * cs[1] + a[2] * sn[1];
    v1[0] = b[0] * cs[2] - b[1] * sn[2]; v1[1] = b[1] * cs[2] + b[0] * sn[2];
    v1[2] = b[2] * cs[3] - b[3] * sn[3]; v1[3] = b[3] * cs[3] + b[2] * sn[3];
}
__device__ __forceinline__ float fr_max(float v) { v = fmaxf(v, __shfl_xor(v, 1)); v = fmaxf(v, __shfl_xor(v, 2)); v = fmaxf(v, __shfl_xor(v, 4)); v = fmaxf(v, __shfl_xor(v, 8)); return v; }
__device__ __forceinline__ float sq8f(f32x4 a, f32x4 b) { return (a[0] * a[0] + a[1] * a[1]) + (a[2] * a[2] + a[3] * a[3]) + (b[0] * b[0] + b[1] * b[1]) + (b[2] * b[2] + b[3] * b[3]); }
struct EpiIn {
    static constexpr bool PERM = true;
    unsigned char* ws;
    __device__ __forceinline__ void operator()(const f32x4 (&acc)[2][2][4][2], const Unit& u, int wr, int wc, int fr, int fq) const {
        const int row0 = u.pm * 256 + wr * 64 + fr, pn = u.pn, cl = wc * 32 + 8 * fq;
        bf16_t* KB = (bf16_t*)(ws + WS_KB); const float* COS = (const float*)(ws + WS_COS); const float* SIN = (const float*)(ws + WS_SIN);
        if (pn < 12) {
            bf16_t* base = (bf16_t*)(ws + WS_QA + (size_t)(pn >> 2) * (32 * MiB)); const int colt = (pn & 3) * 256 + cl; const float qsc = pn < 4 ? 0.125f * LOG2E : 1.f;
#pragma unroll
            for (int ai = 0; ai < 2; ++ai)
#pragma unroll
                for (int m = 0; m < 4; ++m) { bf16_t* rowp = base + (size_t)(row0 + ai * 128 + m * 16) * 1024 + colt;
#pragma unroll
                    for (int bj = 0; bj < 2; ++bj) *(u32x4*)(rowp + bj * 128) = pack8(acc[ai][bj][m][0] * qsc, acc[ai][bj][m][1] * qsc); }
            if (pn >= 4 && pn < 8) {
                float mx[2] = {0.f, 0.f};
#pragma unroll
                for (int ai = 0; ai < 2; ++ai)
#pragma unroll
                    for (int m = 0; m < 4; ++m)
#pragma unroll
                        for (int bj = 0; bj < 2; ++bj) { float q = sq8f(acc[ai][bj][m][0], acc[ai][bj][m][1]); q += __shfl_xor(q, 16); q += __shfl_xor(q, 32); mx[bj] = fmaxf(mx[bj], q); }
#pragma unroll
                for (int bj = 0; bj < 2; ++bj) { const float v = fr_max(mx[bj]); if (fr == 0 && fq == 0) atomicMax((unsigned*)(ws + WS_KMXA) + ((2 * (pn - 4) + bj) * 2 + (wc >> 1)) * 2 + (wc & 1), __float_as_uint(v)); }
            }
        } else if (pn < 15) {
            const bool isq = pn < 14; bf16_t* base = (bf16_t*)(ws + (isq ? WS_CQ : WS_CKV)); const int ld = isq ? QLR : KVLR, colt = isq ? (pn - 12) * 256 + cl : cl; float* ssq = (float*)(ws + (isq ? WS_SSQQ : WS_SSQKV));
#pragma unroll
            for (int ai = 0; ai < 2; ++ai)
#pragma unroll
                for (int m = 0; m < 4; ++m) { const int row = row0 + ai * 128 + m * 16; bf16_t* rowp = base + (size_t)row * ld + colt; float s = 0.f;
#pragma unroll
                    for (int bj = 0; bj < 2; ++bj) { const f32x4 a = acc[ai][bj][m][0], b = acc[ai][bj][m][1];
                        s += (a[0] * a[0] + a[1] * a[1]) + (a[2] * a[2] + a[3] * a[3]) + (b[0] * b[0] + b[1] * b[1]) + (b[2] * b[2] + b[3] * b[3]);
                        *(u32x4*)(rowp + bj * 128) = pack8(a, b); }
                    s += __shfl_xor(s, 16); s += __shfl_xor(s, 32);
                    if (fq == 0) atomicAdd(ssq + row, s); }
        } else {
            if (wc < 2) {
#pragma unroll
                for (int ai = 0; ai < 2; ++ai)
#pragma unroll
                    for (int m = 0; m < 4; ++m) { const int row = row0 + ai * 128 + m * 16; const int i0 = cl >> 1;
                        const f32x4 cs = *(const f32x4*)(COS + (size_t)row * 32 + i0), sn = *(const f32x4*)(SIN + (size_t)row * 32 + i0);
                        f32x4 a = acc[ai][0][m][0], b = acc[ai][0][m][1]; rope8(a, b, cs, sn); const u32x4 w = pack8(a, b);
                        bf16_t* rowp = KB + (size_t)row * NQB + 128 + cl;
#pragma unroll
                        for (int h = 0; h < 8; ++h) *(u32x4*)(rowp + h * 192) = w; }
                float mxr = 0.f;
#pragma unroll
                for (int ai = 0; ai < 2; ++ai)
#pragma unroll
                    for (int m = 0; m < 4; ++m) { float q = sq8f(acc[ai][0][m][0], acc[ai][0][m][1]); q += __shfl_xor(q, 16); q += __shfl_xor(q, 32); mxr = fmaxf(mxr, q); }
                mxr = fr_max(mxr); if (fr == 0 && fq == 0) atomicMax((unsigned*)(ws + WS_KMXR) + wc, __float_as_uint(mxr));
            }
        }
    }
};
struct EpiQB {
    static constexpr bool PERM = true;
    bf16_t* QB; const float *SSQ, *COS, *SIN;
    __device__ __forceinline__ void operator()(const f32x4 (&acc)[2][2][4][2], const Unit& u, int wr, int wc, int fr, int fq) const {
        const int row0 = u.pm * 256 + wr * 64 + fr;
#pragma unroll
        for (int ai = 0; ai < 2; ++ai)
#pragma unroll
            for (int m = 0; m < 4; ++m) { const int row = row0 + ai * 128 + m * 16; const float rstd = rsqrtf(SSQ[row] * (1.f / QLR) + EPS) * (0.07216878364870322f * LOG2E);
#pragma unroll
                for (int bj = 0; bj < 2; ++bj) { const int colw = u.pn * 256 + bj * 128 + wc * 32, hw = colw / 192, w = colw - hw * 192, col = colw + 8 * fq;
                    f32x4 a = acc[ai][bj][m][0] * rstd, b = acc[ai][bj][m][1] * rstd;
                    if (w >= 128) { const int i0 = ((w - 128) >> 1) + 4 * fq;
                        const f32x4 cs = *(const f32x4*)(COS + (size_t)row * 32 + i0), sn = *(const f32x4*)(SIN + (size_t)row * 32 + i0); rope8(a, b, cs, sn); }
                    *(u32x4*)(QB + (size_t)row * NQB + col) = pack8(a, b); } }
    }
};
struct EpiKV {
    static constexpr bool PERM = true;
    bf16_t *KB, *VB; const float* SSQ; unsigned* KMX;
    __device__ __forceinline__ void operator()(const f32x4 (&acc)[2][2][4][2], const Unit& u, int wr, int wc, int fr, int fq) const {
        const int row0 = u.pm * 256 + wr * 64 + fr, h = u.pn, cl = wc * 32 + 8 * fq; float mx = 0.f;
#pragma unroll
        for (int ai = 0; ai < 2; ++ai)
#pragma unroll
            for (int m = 0; m < 4; ++m) { const int row = row0 + ai * 128 + m * 16; const float rstd = rsqrtf(SSQ[row] * (1.f / KVLR) + EPS);
                { float q = sq8f(acc[ai][0][m][0] * rstd, acc[ai][0][m][1] * rstd); q += __shfl_xor(q, 16); q += __shfl_xor(q, 32); mx = fmaxf(mx, q); }
                *(u32x4*)(KB + (size_t)row * NQB + h * 192 + cl) = pack8(acc[ai][0][m][0] * rstd, acc[ai][0][m][1] * rstd);
                *(u32x4*)(VB + (size_t)row * 1024 + h * 128 + cl) = pack8(acc[ai][1][m][0] * rstd, acc[ai][1][m][1] * rstd); }
        mx = fr_max(mx); if (fr == 0 && fq == 0) atomicMax(KMX + h * 4 + wc, __float_as_uint(mx));
    }
};
struct EpiRes {
    static constexpr bool PERM = false;
    const float* base; float* out;
    __device__ __forceinline__ void operator()(const f32x4 (&acc)[2][2][4][2], const Unit& u, int wr, int wc, int fr, int fq) const {
        const int row0 = u.pm * 256 + wr * 64 + fr, col0 = u.pn * 256 + wc * 32 + 4 * fq;
#pragma unroll
        for (int ai = 0; ai < 2; ++ai)
#pragma unroll
            for (int m = 0; m < 4; ++m) { const size_t off = (size_t)(row0 + ai * 128 + m * 16) * DM + col0;
#pragma unroll
                for (int bj = 0; bj < 2; ++bj)
#pragma unroll
                    for (int n = 0; n < 2; ++n) { const f32x4 bs = *(const f32x4*)(base + off + bj * 128 + n * 16); *(f32x4*)(out + off + bj * 128 + n * 16) = bs + acc[ai][bj][m][n]; } }
    }
};
struct EpiResH {
    static constexpr bool PERM = false;
    const float* base; float* out; bf16_t* H2; float* ssq;
    __device__ __forceinline__ void operator()(const f32x4 (&acc)[2][2][4][2], const Unit& u, int wr, int wc, int fr, int fq) const {
        const int row0 = u.pm * 256 + wr * 64 + fr, col0 = u.pn * 256 + wc * 32 + 4 * fq;
#pragma unroll
        for (int ai = 0; ai < 2; ++ai)
#pragma unroll
            for (int m = 0; m < 4; ++m) { const int row = row0 + ai * 128 + m * 16; const size_t off = (size_t)row * DM + col0; float s = 0.f;
#pragma unroll
                for (int bj = 0; bj < 2; ++bj)
#pragma unroll
                    for (int n = 0; n < 2; ++n) { const f32x4 v = *(const f32x4*)(base + off + bj * 128 + n * 16) + acc[ai][bj][m][n]; *(f32x4*)(out + off + bj * 128 + n * 16) = v;
                        s += (v[0] * v[0] + v[1] * v[1]) + (v[2] * v[2] + v[3] * v[3]);
                        u32x2 w; w.x = cvt_pk_bf16(v[0], v[1]); w.y = cvt_pk_bf16(v[2], v[3]); *(u32x2*)(H2 + off + bj * 128 + n * 16) = w; }
                s += __shfl_xor(s, 16); s += __shfl_xor(s, 32);
                if (fq == 0) atomicAdd(ssq + row, s); }
    }
};
struct EpiGU {
    static constexpr bool PERM = true;
    bf16_t* ACT; const float* ssq;
    __device__ __forceinline__ void operator()(const f32x4 (&acc)[2][2][4][2], const Unit& u, int wr, int wc, int fr, int fq) const {
        const int row0 = u.pm * 256 + wr * 64 + fr, col = u.pn * 128 + wc * 32 + 8 * fq;
#pragma unroll
        for (int ai = 0; ai < 2; ++ai)
#pragma unroll
            for (int m = 0; m < 4; ++m) { f32x4 r[2]; const float rstd = rsqrtf(ssq[row0 + ai * 128 + m * 16] * (1.f / DM) + EPS);
#pragma unroll
                for (int n = 0; n < 2; ++n) { const f32x4 g = acc[ai][0][m][n] * rstd, up = acc[ai][1][m][n] * rstd;
#pragma unroll
                    for (int j = 0; j < 4; ++j) r[n][j] = g[j] * up[j] * __builtin_amdgcn_rcpf(1.f + __builtin_amdgcn_exp2f(-g[j] * LOG2E)); }
                *(u32x4*)(ACT + (size_t)(row0 + ai * 128 + m * 16) * DFF + col) = pack8(r[0], r[1]); }
    }
};

namespace att {
constexpr int NW = 8, QBLK = 32, KVBLK = 64;
constexpr float THR2 = 8.f * LOG2E;
constexpr int SHM_V = KVBLK * 128 * 2;
constexpr int OFF_K = 2 * SHM_V, OFF_WS = OFF_K + 2 * 64 * 192 * 2, OFF_TBL = OFF_WS + NW * 256, OFF_QL = OFF_TBL + 2048, ATT_LDS = OFF_QL + NW * 8192;
constexpr int OFF_KA = 65536, OFF_WSA = 98304, OFF_TBLA = 100352;
constexpr int OFF_K3 = 3 * SHM_V, OFF_WS3 = OFF_K3 + 3 * 24576, OFF_TBL3 = OFF_WS3 + NW * 256;
#ifdef NO_SBAR
#define SBAR() do {} while (0)
#else
#define SBAR() __builtin_amdgcn_sched_barrier(0)
#endif
__device__ __forceinline__ int crow(int r, int hi) { return (r & 3) + 8 * (r >> 2) + 4 * hi; }
template <int DQK> __device__ __forceinline__ int koff(int row, int c) { const int s = ((row >> 1) & 1) | (((row >> 3) & 3) << 1); return row * (DQK * 2) + ((c ^ s) << 4); }
__device__ __forceinline__ int v_st(int k, int c) { const int kk = (k & ~0xC) | ((k & 4) << 1) | ((k & 8) >> 1); return ((kk >> 3) * 4 + (c >> 5)) * 512 + ((kk & 7) * 32 + (c & 31)) * 2; }
__device__ __forceinline__ int v_rd_base(int lane) { return ((lane & 3) << 3) | (((lane >> 2) & 3) << 6) | (((lane >> 4) & 1) << 5) | (((lane >> 5) & 1) << 8); }
constexpr int v_rd_off(int d0, int ks, int half) { return d0 * 512 + ks * 4096 + half * 2048; }
template <int OFF> __device__ __forceinline__ s16x4 tr_read(int vb) { s16x4 r; asm volatile("ds_read_b64_tr_b16 %0, %1 offset:%2" : "=&v"(r) : "v"(vb), "i"(OFF) : "memory"); return r; }
template <int D0> __device__ __forceinline__ void pv_one(f32x16& od, int vb, bf16x8 pa0, bf16x8 pa1, bf16x8 pa2, bf16x8 pa3) {
    s16x4 l0 = tr_read<v_rd_off(D0, 0, 0)>(vb), h0 = tr_read<v_rd_off(D0, 0, 1)>(vb), l1 = tr_read<v_rd_off(D0, 1, 0)>(vb), h1 = tr_read<v_rd_off(D0, 1, 1)>(vb);
    s16x4 l2 = tr_read<v_rd_off(D0, 2, 0)>(vb), h2 = tr_read<v_rd_off(D0, 2, 1)>(vb), l3 = tr_read<v_rd_off(D0, 3, 0)>(vb), h3 = tr_read<v_rd_off(D0, 3, 1)>(vb);
#ifdef NO_SBAR
    asm volatile("s_waitcnt lgkmcnt(0)" : "+v"(l0), "+v"(h0), "+v"(l1), "+v"(h1), "+v"(l2), "+v"(h2), "+v"(l3), "+v"(h3) :: "memory");
#else
    asm volatile("s_waitcnt lgkmcnt(0)" ::: "memory"); SBAR();
#endif
#define PK(L, H) (bf16x8){L[0], L[1], L[2], L[3], H[0], H[1], H[2], H[3]}
    od = __builtin_amdgcn_mfma_f32_32x32x16_bf16(pa0, PK(l0, h0), od, 0, 0, 0);
    od = __builtin_amdgcn_mfma_f32_32x32x16_bf16(pa1, PK(l1, h1), od, 0, 0, 0);
    od = __builtin_amdgcn_mfma_f32_32x32x16_bf16(pa2, PK(l2, h2), od, 0, 0, 0);
    od = __builtin_amdgcn_mfma_f32_32x32x16_bf16(pa3, PK(l3, h3), od, 0, 0, 0);
#undef PK
}
__device__ __forceinline__ void pv_d0(f32x16 (&o)[4], int vb, bf16x8 pa0, bf16x8 pa1, bf16x8 pa2, bf16x8 pa3) {
    pv_one<0>(o[0], vb, pa0, pa1, pa2, pa3); pv_one<1>(o[1], vb, pa0, pa1, pa2, pa3); pv_one<2>(o[2], vb, pa0, pa1, pa2, pa3); pv_one<3>(o[3], vb, pa0, pa1, pa2, pa3);
}
template <bool BAND>
__device__ __forceinline__ void partialSM(f32x16& p0, f32x16& p1, float& m_reg, float& mn, float& alpha, float C, float cb, const LAS float* tbl, int relb, int hi) {
    if constexpr (BAND) {
#pragma unroll
        for (int r = 0; r < 16; ++r) { int i0 = relb + crow(r, hi), i1 = i0 + 32; i0 = min(max(i0, 0), 256); i1 = min(max(i1, 0), 256);
            p0[r] = fmaf(p0[r], C, tbl[i0]); p1[r] = fmaf(p1[r], C, tbl[i1]); }
    }
    float pmax = p0[0];
#pragma unroll
    for (int r = 1; r < 16; ++r) pmax = fmaxf(pmax, p0[r]);
#pragma unroll
    for (int r = 0; r < 16; ++r) pmax = fmaxf(pmax, p1[r]);
    { auto rr = __builtin_amdgcn_permlane32_swap(__float_as_uint(pmax), __float_as_uint(pmax), false, false);
      pmax = fmaxf(__uint_as_float(rr[0]), __uint_as_float(rr[1])); }
    const float ymax = BAND ? pmax : fmaf(pmax, C, cb);
    if (__builtin_expect(__all(ymax - m_reg <= THR2), 1)) { mn = m_reg; alpha = 1.f; }
    else { mn = fmaxf(m_reg, ymax); alpha = __builtin_amdgcn_exp2f(m_reg - mn); m_reg = mn; }
    if constexpr (BAND) {
#pragma unroll
        for (int r = 0; r < 16; ++r) { p0[r] -= mn; p1[r] -= mn; }
    } else {
        const float a = cb - mn;
#pragma unroll
        for (int r = 0; r < 16; ++r) { p0[r] = fmaf(p0[r], C, a); p1[r] = fmaf(p1[r], C, a); }
    }
#pragma unroll
    for (int r = 0; r < 16; ++r) p0[r] = __builtin_amdgcn_exp2f(p0[r]);
}
__device__ __forceinline__ void finishSM(f32x16& p0, f32x16& p1, float alpha, float& l_reg, bf16x8& pa0, bf16x8& pa1, bf16x8& pa2, bf16x8& pa3) {
#pragma unroll
    for (int r = 0; r < 16; ++r) p1[r] = __builtin_amdgcn_exp2f(p1[r]);
    float ps = 0;
#pragma unroll
    for (int r = 0; r < 16; ++r) ps += p0[r];
#pragma unroll
    for (int r = 0; r < 16; ++r) ps += p1[r];
    { auto rr = __builtin_amdgcn_permlane32_swap(__float_as_uint(ps), __float_as_uint(ps), false, false);
      ps = __uint_as_float(rr[0]) + __uint_as_float(rr[1]); }
    l_reg = l_reg * alpha + ps;
#define PK4(P, BASE, OUT) do { unsigned a0 = cvt_pk_bf16(P[BASE + 0], P[BASE + 1]), a1 = cvt_pk_bf16(P[BASE + 2], P[BASE + 3]);   \
    unsigned b0 = cvt_pk_bf16(P[BASE + 4], P[BASE + 5]), b1 = cvt_pk_bf16(P[BASE + 6], P[BASE + 7]);                              \
    auto r0 = __builtin_amdgcn_permlane32_swap(a0, b0, false, false); auto r1 = __builtin_amdgcn_permlane32_swap(a1, b1, false, false); \
    u32x4 w = {r0[0], r1[0], r0[1], r1[1]}; OUT = *reinterpret_cast<bf16x8*>(&w); } while (0)
    PK4(p0, 0, pa0); PK4(p0, 8, pa1); PK4(p1, 0, pa2); PK4(p1, 8, pa3);
#undef PK4
}
template <int DQK, int QREG>
__device__ __forceinline__ void qkt(f32x16& p0, f32x16& p1, const LAS unsigned char* Ks, const bf16x8 (&qr)[QREG], const LAS unsigned char* ql, int r32, int hi) {
    p0 = f32x16{}; p1 = f32x16{};
#pragma unroll
    for (int d0 = 0; d0 < DQK / 16; ++d0) { const int c = d0 * 2 + hi;
        const bf16x8 b0 = *(const LAS bf16x8*)(Ks + koff<DQK>(r32, c));
        const bf16x8 b1 = *(const LAS bf16x8*)(Ks + koff<DQK>(32 + r32, c));
        bf16x8 q; if (d0 < QREG) q = qr[d0 < QREG ? d0 : 0]; else q = *(const LAS bf16x8*)(ql + (d0 - QREG) * 1024);
        p0 = __builtin_amdgcn_mfma_f32_32x32x16_bf16(b0, q, p0, 0, 0, 0);
        p1 = __builtin_amdgcn_mfma_f32_32x32x16_bf16(b1, q, p1, 0, 0, 0); }
}

template <int OFF> __device__ __forceinline__ bf16x8 ldsr128(int addr) { bf16x8 r; asm volatile("ds_read_b128 %0, %1 offset:%2" : "=v"(r) : "v"(addr), "i"(OFF) : "memory"); return r; }
template <int BUF, int QREG>
__device__ __forceinline__ void qkt192(f32x16& p0, f32x16& p1, const int (&kb)[4], const bf16x8 (&qr)[QREG], const LAS unsigned char* ql) {
    p0 = f32x16{}; p1 = f32x16{};
#define QKT_G(G) do { \
        bf16x8 a0 = ldsr128<BUF * 24576 + 128 * G>(kb[0]), b0 = ldsr128<BUF * 24576 + 128 * G + 12288>(kb[0]); \
        bf16x8 a1 = ldsr128<BUF * 24576 + 128 * G>(kb[1]), b1 = ldsr128<BUF * 24576 + 128 * G + 12288>(kb[1]); \
        bf16x8 a2 = ldsr128<BUF * 24576 + 128 * G>(kb[2]), b2 = ldsr128<BUF * 24576 + 128 * G + 12288>(kb[2]); \
        bf16x8 a3 = ldsr128<BUF * 24576 + 128 * G>(kb[3]), b3 = ldsr128<BUF * 24576 + 128 * G + 12288>(kb[3]); \
        bf16x8 q0, q1, q2, q3; \
        if (4 * G + 0 < QREG) q0 = qr[4 * G + 0 < QREG ? 4 * G + 0 : 0]; else q0 = *(const LAS bf16x8*)(ql + (4 * G + 0 - QREG) * 1024); \
        if (4 * G + 1 < QREG) q1 = qr[4 * G + 1 < QREG ? 4 * G + 1 : 0]; else q1 = *(const LAS bf16x8*)(ql + (4 * G + 1 - QREG) * 1024); \
        if (4 * G + 2 < QREG) q2 = qr[4 * G + 2 < QREG ? 4 * G + 2 : 0]; else q2 = *(const LAS bf16x8*)(ql + (4 * G + 2 - QREG) * 1024); \
        if (4 * G + 3 < QREG) q3 = qr[4 * G + 3 < QREG ? 4 * G + 3 : 0]; else q3 = *(const LAS bf16x8*)(ql + (4 * G + 3 - QREG) * 1024); \
        asm volatile("s_waitcnt lgkmcnt(0)" : "+v"(a0), "+v"(b0), "+v"(a1), "+v"(b1), "+v"(a2), "+v"(b2), "+v"(a3), "+v"(b3) :: "memory"); \
        p0 = __builtin_amdgcn_mfma_f32_32x32x16_bf16(a0, q0, p0, 0, 0, 0); p1 = __builtin_amdgcn_mfma_f32_32x32x16_bf16(b0, q0, p1, 0, 0, 0); \
        p0 = __builtin_amdgcn_mfma_f32_32x32x16_bf16(a1, q1, p0, 0, 0, 0); p1 = __builtin_amdgcn_mfma_f32_32x32x16_bf16(b1, q1, p1, 0, 0, 0); \
        p0 = __builtin_amdgcn_mfma_f32_32x32x16_bf16(a2, q2, p0, 0, 0, 0); p1 = __builtin_amdgcn_mfma_f32_32x32x16_bf16(b2, q2, p1, 0, 0, 0); \
        p0 = __builtin_amdgcn_mfma_f32_32x32x16_bf16(a3, q3, p0, 0, 0, 0); p1 = __builtin_amdgcn_mfma_f32_32x32x16_bf16(b3, q3, p1, 0, 0, 0); } while (0)
    QKT_G(0); QKT_G(1); QKT_G(2);
#undef QKT_G
}
template <int DQK, bool BIAS, int ldq, int ldk, int ldv, int SDEPTH, int QREG>
__device__ __forceinline__ void attn_body(const bf16_t* __restrict__ Qb, const bf16_t* __restrict__ Kh, const bf16_t* __restrict__ Vh,
                                          LAS unsigned char* lds, float C, int q0, float cb_lo, float cb_hi, f32x16 (&o)[4]) {
    constexpr int NK = DQK / 64, CPR = DQK / 8, SHM_K = 64 * DQK * 2, NLD = 2 + NK;
    int tid_ = threadIdx.x; asm volatile("" : "+v"(tid_));
    const int tid = tid_, wid = tid >> 6, lane = tid & 63, r32 = lane & 31, hi = lane >> 5;
    LAS unsigned char* V_lds = lds; LAS unsigned char* K_lds = lds + OFF_K;
    LAS float* ws = (LAS float*)(lds + OFF_WS) + wid * 64; LAS float* li_l = ws; LAS float* al_l = ws + 32;
    const LAS float* tbl = (const LAS float*)(lds + OFF_TBL);
    float m_reg = -1e30f, l_reg = 0;
#pragma unroll
    for (int d = 0; d < 4; ++d) o[d] = f32x16{};
    bf16x8 qr[QREG];
    const bf16_t* Qw = Qb + (size_t)(wid * QBLK + r32) * ldq + hi * 8;
    LAS unsigned char* ql = lds + OFF_QL + wid * 8192 + lane * 16;
#pragma unroll
    for (int d0 = 0; d0 < DQK / 16; ++d0) { const bf16x8 q = *(const bf16x8*)(Qw + d0 * 16); if (d0 < QREG) qr[d0 < QREG ? d0 : 0] = q; else *(LAS bf16x8*)(ql + (d0 - QREG) * 1024) = q; }
    const int sr = tid >> 4, sc = (tid & 15) * 8, vst0 = v_st(sr, sc), vst1 = vst0 + 8192;
    unsigned kgo[NK]; int klo[NK];
#pragma unroll
    for (int i = 0; i < NK; ++i) { const int id = tid + 512 * i, row = id / CPR, c = id - row * CPR; kgo[i] = (unsigned)(row * ldk + c * 8) * 2u; klo[i] = koff<DQK>(row, c); }
    const unsigned vgo0 = (unsigned)(sr * ldv + sc) * 2u, vgo1 = vgo0 + (unsigned)(32 * ldv * 2);
    const int vb0 = (int)(uintptr_t)V_lds + v_rd_base(lane);
    int kb4[4];
#pragma unroll
    for (int e = 0; e < 4; ++e) kb4[e] = (int)(uintptr_t)K_lds + koff<DQK>(r32, 2 * e + hi);
#define QKT(P0, P1, BUF) do { if constexpr (DQK == 192) qkt192<BUF, QREG>(P0, P1, kb4, qr, ql); else qkt<DQK, QREG>(P0, P1, K_lds + BUF * SHM_K, qr, ql, r32, hi); } while (0)
    struct Slot { bf16x8 v0, v1, k[NK]; } slots[SDEPTH];
#define sl0 slots[0]
#define sl1 slots[SDEPTH - 1]
    const int qabs = q0 + wid * QBLK + r32;
#define SLOAD(sl, k0) do { const char* vb_ = (const char*)(Vh + (size_t)(k0) * ldv); const char* kb_ = (const char*)(Kh + (size_t)(k0) * ldk); \
    sl.v0 = *(const bf16x8*)(vb_ + vgo0); sl.v1 = *(const bf16x8*)(vb_ + vgo1); \
    _Pragma("unroll") for (int _i = 0; _i < NK; ++_i) sl.k[_i] = *(const bf16x8*)(kb_ + kgo[_i]); } while (0)
#define SWRITE(b, sl) do { *(LAS bf16x8*)(V_lds + (b) * SHM_V + vst0) = sl.v0; *(LAS bf16x8*)(V_lds + (b) * SHM_V + vst1) = sl.v1; \
    _Pragma("unroll") for (int _i = 0; _i < NK; ++_i) *(LAS bf16x8*)(K_lds + (b) * SHM_K + klo[_i]) = sl.k[_i]; } while (0)
#define SWAIT() do { if constexpr (SDEPTH == 1) asm volatile("s_waitcnt vmcnt(0)" ::: "memory"); else if constexpr (NLD == 3) asm volatile("s_waitcnt vmcnt(3)" ::: "memory"); else asm volatile("s_waitcnt vmcnt(5)" ::: "memory"); } while (0)
#define RESC(a) do { if (__any((a) < 1.f)) { if (hi == 0) al_l[r32] = (a); asm volatile("s_waitcnt lgkmcnt(0)" ::: "memory"); \
    _Pragma("unroll") for (int d = 0; d < 4; ++d) _Pragma("unroll") for (int r = 0; r < 16; ++r) o[d][r] *= al_l[crow(r, hi)]; } } while (0)
#define PSM(P0, P1, MN, AL, t) do { if constexpr (BIAS) { const int k0_ = (t) * KVBLK; \
        if (k0_ <= q0 - 191 || k0_ >= q0 + 383) partialSM<false>(P0, P1, m_reg, MN, AL, C, k0_ < q0 ? cb_lo : cb_hi, tbl, 0, hi); \
        else partialSM<true>(P0, P1, m_reg, MN, AL, C, 0.f, tbl, k0_ - qabs + 128, hi); } \
      else partialSM<false>(P0, P1, m_reg, MN, AL, C, 0.f, tbl, 0, hi); } while (0)
    f32x16 pA0, pA1, pB0, pB1; float mnA, mnB, alA, alB; bf16x8 pa0, pa1, pa2, pa3; const int NT = S / KVBLK;
    if (wid >= 4) __builtin_amdgcn_s_setprio(1);
    SLOAD(sl0, 0); asm volatile("s_waitcnt vmcnt(0)" ::: "memory"); SWRITE(0, sl0); __syncthreads();
    QKT(pA0, pA1, 0); PSM(pA0, pA1, mnA, alA, 0);
    SLOAD(sl1, KVBLK); if constexpr (SDEPTH == 2) SLOAD(sl0, 2 * KVBLK);
    SWAIT(); SWRITE(1, sl1); __syncthreads();
    for (int j = 1; j + 1 < NT; j += 2) {
        SBAR(); QKT(pB0, pB1, 1);
        finishSM(pA0, pA1, alA, l_reg, pa0, pa1, pa2, pa3); SBAR();
        SLOAD(sl1, (j + SDEPTH) * KVBLK); SBAR();
        pv_d0(o, vb0, pa0, pa1, pa2, pa3); PSM(pB0, pB1, mnB, alB, j);
        __syncthreads(); SWAIT(); SWRITE(0, sl0);
        RESC(alB); __syncthreads();
        SBAR(); QKT(pA0, pA1, 0);
        finishSM(pB0, pB1, alB, l_reg, pa0, pa1, pa2, pa3); SBAR();
        if (SDEPTH == 1 || j + 3 < NT) SLOAD(sl0, (j + 1 + SDEPTH) * KVBLK); SBAR();
        pv_d0(o, vb0 + SHM_V, pa0, pa1, pa2, pa3); PSM(pA0, pA1, mnA, alA, j + 1);
        __syncthreads(); SWAIT(); SWRITE(1, sl1);
        RESC(alA); __syncthreads();
    }
    SBAR(); QKT(pB0, pB1, 1);
    finishSM(pA0, pA1, alA, l_reg, pa0, pa1, pa2, pa3); SBAR();
    pv_d0(o, vb0, pa0, pa1, pa2, pa3); PSM(pB0, pB1, mnB, alB, NT - 1);
    __syncthreads(); RESC(alB);
    finishSM(pB0, pB1, alB, l_reg, pa0, pa1, pa2, pa3); SBAR();
    pv_d0(o, vb0 + SHM_V, pa0, pa1, pa2, pa3);
    __builtin_amdgcn_s_setprio(0);
    if (hi == 0) li_l[r32] = l_reg; asm volatile("s_waitcnt lgkmcnt(0)" ::: "memory");
#pragma unroll
    for (int r = 0; r < 16; ++r) { const float rl = __builtin_amdgcn_rcpf(li_l[crow(r, hi)]);
#pragma unroll
        for (int d = 0; d < 4; ++d) o[d][r] *= rl; }
#undef SLOAD
#undef sl0
#undef sl1
#undef SWRITE
#undef SWAIT
#undef RESC
#undef PSM
#undef QKT
}

template <int DQK, bool BIAS, int ldq, int ldk, int ldv, int QREG>
__device__ __forceinline__ void attn_body1(const bf16_t* __restrict__ Qb, const bf16_t* __restrict__ Kh, const bf16_t* __restrict__ Vh,
                                           LAS unsigned char* lds, float C, int q0, float cb_lo, float cb_hi, f32x16 (&o)[4]) {
    constexpr int NK = DQK / 64, CPR = DQK / 8, SHM_K = 64 * DQK * 2;
    int tid_ = threadIdx.x; asm volatile("" : "+v"(tid_));
    const int tid = tid_, wid = tid >> 6, lane = tid & 63, r32 = lane & 31, hi = lane >> 5;
    LAS unsigned char* V_lds = lds; LAS unsigned char* K_lds = lds + OFF_K;
    LAS float* ws = (LAS float*)(lds + OFF_WS) + wid * 64; LAS float* li_l = ws; LAS float* al_l = ws + 32;
    const LAS float* tbl = (const LAS float*)(lds + OFF_TBL);
    float m_reg = -1e30f, l_reg = 0;
#pragma unroll
    for (int d = 0; d < 4; ++d) o[d] = f32x16{};
    bf16x8 qr[QREG];
    const bf16_t* Qw = Qb + (size_t)(wid * QBLK + r32) * ldq + hi * 8;
    LAS unsigned char* ql = lds + OFF_QL + wid * 8192 + lane * 16;
#pragma unroll
    for (int d0 = 0; d0 < DQK / 16; ++d0) { const bf16x8 q = *(const bf16x8*)(Qw + d0 * 16); if (d0 < QREG) qr[d0 < QREG ? d0 : 0] = q; else *(LAS bf16x8*)(ql + (d0 - QREG) * 1024) = q; }
    const int sr = tid >> 4, sc = (tid & 15) * 8, vst0 = v_st(sr, sc), vst1 = vst0 + 8192;
    unsigned kgo[NK]; int klo[NK];
#pragma unroll
    for (int i = 0; i < NK; ++i) { const int id = tid + 512 * i, row = id / CPR, c = id - row * CPR; kgo[i] = (unsigned)(row * ldk + c * 8) * 2u; klo[i] = koff<DQK>(row, c); }
    const unsigned vgo0 = (unsigned)(sr * ldv + sc) * 2u, vgo1 = vgo0 + (unsigned)(32 * ldv * 2);
    const int vb0 = (int)(uintptr_t)V_lds + v_rd_base(lane);
    bf16x8 sv0, sv1, sk[NK];
    const int qabs = q0 + wid * QBLK + r32;
#define SLOAD1(k0) do { const char* vb_ = (const char*)(Vh + (size_t)(k0) * ldv); const char* kb_ = (const char*)(Kh + (size_t)(k0) * ldk); \
    sv0 = *(const bf16x8*)(vb_ + vgo0); sv1 = *(const bf16x8*)(vb_ + vgo1); \
    _Pragma("unroll") for (int _i = 0; _i < NK; ++_i) sk[_i] = *(const bf16x8*)(kb_ + kgo[_i]); } while (0)
#define SWRITE1(b) do { *(LAS bf16x8*)(V_lds + (b) * SHM_V + vst0) = sv0; *(LAS bf16x8*)(V_lds + (b) * SHM_V + vst1) = sv1; \
    _Pragma("unroll") for (int _i = 0; _i < NK; ++_i) *(LAS bf16x8*)(K_lds + (b) * SHM_K + klo[_i]) = sk[_i]; } while (0)
    constexpr int NT = S / KVBLK;
    if (wid >= 4) __builtin_amdgcn_s_setprio(1);
    SLOAD1(0); asm volatile("s_waitcnt vmcnt(0)" ::: "memory"); SWRITE1(0); __syncthreads();
    for (int j = 0; j < NT; ++j) {
        const int b = j & 1;
        if (j + 1 < NT) SLOAD1((j + 1) * KVBLK);
        f32x16 p0, p1; float mn, al; bf16x8 pa0, pa1, pa2, pa3;
        qkt<DQK, QREG>(p0, p1, K_lds + b * SHM_K, qr, ql, r32, hi);
        if constexpr (BIAS) { const int k0_ = j * KVBLK;
            if (k0_ <= q0 - 191) partialSM<false>(p0, p1, m_reg, mn, al, C, cb_lo, tbl, 0, hi);
            else if (k0_ >= q0 + 383) partialSM<false>(p0, p1, m_reg, mn, al, C, cb_hi, tbl, 0, hi);
            else partialSM<true>(p0, p1, m_reg, mn, al, C, 0.f, tbl, k0_ - qabs + 128, hi); }
        else partialSM<false>(p0, p1, m_reg, mn, al, C, 0.f, tbl, 0, hi);
        finishSM(p0, p1, al, l_reg, pa0, pa1, pa2, pa3);
        if (__any(al < 1.f)) { if (hi == 0) al_l[r32] = al; asm volatile("s_waitcnt lgkmcnt(0)" ::: "memory");
#pragma unroll
            for (int d = 0; d < 4; ++d)
#pragma unroll
                for (int r = 0; r < 16; ++r) o[d][r] *= al_l[crow(r, hi)]; }
        pv_d0(o, vb0 + b * SHM_V, pa0, pa1, pa2, pa3);
        if (j + 1 < NT) SWRITE1(b ^ 1);
        __syncthreads();
    }
    __builtin_amdgcn_s_setprio(0);
    if (hi == 0) li_l[r32] = l_reg; asm volatile("s_waitcnt lgkmcnt(0)" ::: "memory");
#pragma unroll
    for (int r = 0; r < 16; ++r) { const float rl = __builtin_amdgcn_rcpf(li_l[crow(r, hi)]);
#pragma unroll
        for (int d = 0; d < 4; ++d) o[d][r] *= rl; }
#undef SLOAD1
#undef SWRITE1
}


template <int BUF>
__device__ __forceinline__ void qkt192n(f32x16& p0, f32x16& p1, const int (&kb)[4], const bf16x8 (&qr)[12], const f32x16& nm) {
#define QKT_G(G) do { \
        bf16x8 a0 = ldsr128<BUF * 24576 + 128 * G>(kb[0]), b0 = ldsr128<BUF * 24576 + 128 * G + 12288>(kb[0]); \
        bf16x8 a1 = ldsr128<BUF * 24576 + 128 * G>(kb[1]), b1 = ldsr128<BUF * 24576 + 128 * G + 12288>(kb[1]); \
        bf16x8 a2 = ldsr128<BUF * 24576 + 128 * G>(kb[2]), b2 = ldsr128<BUF * 24576 + 128 * G + 12288>(kb[2]); \
        bf16x8 a3 = ldsr128<BUF * 24576 + 128 * G>(kb[3]), b3 = ldsr128<BUF * 24576 + 128 * G + 12288>(kb[3]); \
        asm volatile("s_waitcnt lgkmcnt(0)" : "+v"(a0), "+v"(b0), "+v"(a1), "+v"(b1), "+v"(a2), "+v"(b2), "+v"(a3), "+v"(b3) :: "memory"); \
        p0 = __builtin_amdgcn_mfma_f32_32x32x16_bf16(a0, qr[4 * G + 0], G == 0 ? nm : p0, 0, 0, 0); p1 = __builtin_amdgcn_mfma_f32_32x32x16_bf16(b0, qr[4 * G + 0], G == 0 ? nm : p1, 0, 0, 0); \
        p0 = __builtin_amdgcn_mfma_f32_32x32x16_bf16(a1, qr[4 * G + 1], p0, 0, 0, 0); p1 = __builtin_amdgcn_mfma_f32_32x32x16_bf16(b1, qr[4 * G + 1], p1, 0, 0, 0); \
        p0 = __builtin_amdgcn_mfma_f32_32x32x16_bf16(a2, qr[4 * G + 2], p0, 0, 0, 0); p1 = __builtin_amdgcn_mfma_f32_32x32x16_bf16(b2, qr[4 * G + 2], p1, 0, 0, 0); \
        p0 = __builtin_amdgcn_mfma_f32_32x32x16_bf16(a3, qr[4 * G + 3], p0, 0, 0, 0); p1 = __builtin_amdgcn_mfma_f32_32x32x16_bf16(b3, qr[4 * G + 3], p1, 0, 0, 0); } while (0)
    QKT_G(0); QKT_G(1); QKT_G(2);
#undef QKT_G
}
__device__ __forceinline__ float sq8(u32x4 w) {
    float s = 0.f;
#pragma unroll
    for (int e = 0; e < 4; ++e) { const float lo = __uint_as_float(w[e] << 16), hi = __uint_as_float(w[e] & 0xffff0000u); s = fmaf(lo, lo, s); s = fmaf(hi, hi, s); }
    return s;
}
template <int DQK, bool BIAS, int ldq, int ldk, int ldv>
__device__ __forceinline__ void attn_f(const bf16_t* __restrict__ Qb, const bf16_t* __restrict__ Kh, const bf16_t* __restrict__ Vh,
                                       LAS unsigned char* lds, int q0, float cb_lo, float cb_hi, float kmax, float bmax, f32x16 (&o)[4]) {
    constexpr int RING = (DQK == 192) ? 3 : 2;
    constexpr int NK = DQK / 64, CPR = DQK / 8, SHM_K = (RING == 3) ? 24576 : 64 * DQK * 2, QREG = DQK / 16, NT = S / KVBLK;
    constexpr bool KPERM = (DQK == 64);
    int tid_ = threadIdx.x; asm volatile("" : "+v"(tid_));
    const int tid = tid_, wid = __builtin_amdgcn_readfirstlane(tid >> 6), lane = tid & 63, r32 = lane & 31, hi = lane >> 5;
    LAS unsigned char* V_lds = lds; LAS unsigned char* K_lds = lds + (RING == 3 ? OFF_K3 : OFF_K);
    LAS float* ws = (LAS float*)(lds + (RING == 3 ? OFF_WS3 : OFF_WS)) + wid * 64; LAS float* li_l = ws;
    const LAS float* tbl = (const LAS float*)(lds + OFF_TBL);
    float l_reg = 0.f;
#pragma unroll
    for (int d = 0; d < 4; ++d) o[d] = f32x16{};
    bf16x8 qr[QREG];
    const bf16_t* Qw = Qb + (size_t)(wid * QBLK + r32) * ldq + hi * 8;
    float qs = 0.f;
#pragma unroll
    for (int d0 = 0; d0 < QREG; ++d0) { qr[d0] = *(const bf16x8*)(Qw + d0 * 16); qs += sq8(__builtin_bit_cast(u32x4, qr[d0])); }
    { auto rr = __builtin_amdgcn_permlane32_swap(__float_as_uint(qs), __float_as_uint(qs), false, false); qs = __uint_as_float(rr[0]) + __uint_as_float(rr[1]); }
    const float nm_ref = -(sqrtf(qs) * kmax + bmax);
    f32x16 nm;
#pragma unroll
    for (int r = 0; r < 16; ++r) nm[r] = nm_ref;
    unsigned kgo[NK], vgo[2];
#pragma unroll
    for (int i = 0; i < NK; ++i) { const int p = (i * 8 + wid) * 64 + lane, rho = p / CPR, cph = p - rho * CPR, sw = ((rho >> 1) & 1) | (((rho >> 3) & 3) << 1), c = cph ^ sw;
        const int k = KPERM ? ((rho & ~0xC) | ((rho & 4) << 1) | ((rho & 8) >> 1)) : rho; kgo[i] = (unsigned)(k * ldk + c * 8) * 2u; }
#pragma unroll
    for (int i = 0; i < 2; ++i) { const int p = (i * 8 + wid) * 64 + lane, sub = p >> 5, w = p & 31, kk = (sub >> 2) * 8 + (w >> 2), k = (kk & ~0xC) | ((kk & 4) << 1) | ((kk & 8) >> 1), col = (sub & 3) * 32 + (w & 3) * 8;
        vgo[i] = (unsigned)(k * ldv + col) * 2u; }
    const int vb0 = (int)(uintptr_t)V_lds + v_rd_base(lane);
    const int qabs = q0 + wid * QBLK + r32;
    int kb4[4];
#pragma unroll
    for (int e = 0; e < 4; ++e) kb4[e] = (int)(uintptr_t)K_lds + koff<DQK>(r32, 2 * e + hi);
    const __amdgpu_buffer_rsrc_t krs = __builtin_amdgcn_make_buffer_rsrc((void*)Kh, 0, 0x7fffffff, 0x00020000), vrs = __builtin_amdgcn_make_buffer_rsrc((void*)Vh, 0, 0x7fffffff, 0x00020000);
#define DMA2(t, KB_, VB_) do { const int ko_ = (t) * (KVBLK * ldk * 2), vo_ = (t) * (KVBLK * ldv * 2); \
    _Pragma("unroll") for (int _i = 0; _i < NK; ++_i) __builtin_amdgcn_raw_ptr_buffer_load_lds(krs, (LAS void*)(K_lds + (KB_) + (_i * 8 + wid) * 1024), 16, kgo[_i], ko_, 0, 0); \
    _Pragma("unroll") for (int _i = 0; _i < 2; ++_i) __builtin_amdgcn_raw_ptr_buffer_load_lds(vrs, (LAS void*)(V_lds + (VB_) + (_i * 8 + wid) * 1024), 16, vgo[_i], vo_, 0, 0); } while (0)
#define PK4(P, BASE, OUT) do { if constexpr (KPERM) { u32x4 w = {cvt_pk_bf16(P[BASE + 0], P[BASE + 1]), cvt_pk_bf16(P[BASE + 2], P[BASE + 3]), cvt_pk_bf16(P[BASE + 4], P[BASE + 5]), cvt_pk_bf16(P[BASE + 6], P[BASE + 7])}; \
        OUT = *reinterpret_cast<bf16x8*>(&w); } else { unsigned a0 = cvt_pk_bf16(P[BASE + 0], P[BASE + 1]), a1 = cvt_pk_bf16(P[BASE + 2], P[BASE + 3]), b0_ = cvt_pk_bf16(P[BASE + 4], P[BASE + 5]), b1_ = cvt_pk_bf16(P[BASE + 6], P[BASE + 7]); \
        auto r0 = __builtin_amdgcn_permlane32_swap(a0, b0_, false, false); auto r1 = __builtin_amdgcn_permlane32_swap(a1, b1_, false, false); \
        u32x4 w = {r0[0], r1[0], r0[1], r1[1]}; OUT = *reinterpret_cast<bf16x8*>(&w); } } while (0)
#define TILEC(KB_, VB_, t, QKB, BANDTILE) do { \
        f32x16 p0, p1; \
        if constexpr (DQK == 192) qkt192n<QKB>(p0, p1, kb4, qr, nm); else \
        { const LAS unsigned char* Ks = K_lds + (KB_); \
          _Pragma("unroll") for (int d0 = 0; d0 < DQK / 16; ++d0) { const int c = d0 * 2 + hi; \
              const bf16x8 b0 = *(const LAS bf16x8*)(Ks + koff<DQK>(r32, c)); const bf16x8 b1 = *(const LAS bf16x8*)(Ks + koff<DQK>(32 + r32, c)); \
              p0 = __builtin_amdgcn_mfma_f32_32x32x16_bf16(b0, qr[d0], d0 == 0 ? nm : p0, 0, 0, 0); p1 = __builtin_amdgcn_mfma_f32_32x32x16_bf16(b1, qr[d0], d0 == 0 ? nm : p1, 0, 0, 0); } } \
        if constexpr (BIAS && BANDTILE) { const int relb = (t) * KVBLK - qabs + 128; \
            _Pragma("unroll") for (int r = 0; r < 16; ++r) { int i0 = relb + (KPERM ? 16 * (r >> 3) + 8 * hi + (r & 7) : crow(r, hi)), i1 = i0 + 32; i0 = min(max(i0, 0), 256); i1 = min(max(i1, 0), 256); p0[r] += tbl[i0]; p1[r] += tbl[i1]; } } \
        _Pragma("unroll") for (int r = 0; r < 16; ++r) { p0[r] = __builtin_amdgcn_exp2f(p0[r]); p1[r] = __builtin_amdgcn_exp2f(p1[r]); } \
        float ps = 0; \
        _Pragma("unroll") for (int r = 0; r < 16; ++r) ps += p0[r]; \
        _Pragma("unroll") for (int r = 0; r < 16; ++r) ps += p1[r]; \
        if constexpr (!KPERM) { auto rr = __builtin_amdgcn_permlane32_swap(__float_as_uint(ps), __float_as_uint(ps), false, false); ps = __uint_as_float(rr[0]) + __uint_as_float(rr[1]); } \
        l_reg += ps; \
        bf16x8 pa0, pa1, pa2, pa3; PK4(p0, 0, pa0); PK4(p0, 8, pa1); PK4(p1, 0, pa2); PK4(p1, 8, pa3); \
        pv_d0(o, vb0 + (VB_), pa0, pa1, pa2, pa3); } while (0)
#define TILE3(B, t) do { if ((t) + 2 < NT) DMA2((t) + 2, (((B) + 2) % 3) * SHM_K, (((B) + 2) % 3) * SHM_V); \
        TILEC((B) * SHM_K, (B) * SHM_V, t, B, false); \
        if ((t) + 2 < NT) asm volatile("s_waitcnt vmcnt(5) lgkmcnt(0)\n\ts_barrier" ::: "memory"); else asm volatile("s_waitcnt vmcnt(0) lgkmcnt(0)\n\ts_barrier" ::: "memory"); } while (0)
#define TILEX(B, t, BANDTILE) do { if ((t) + 1 < NT) DMA2((t) + 1, ((B) ^ 1) * 8192, ((B) ^ 1) * 16384); \
        TILEC((B) * 8192, (B) * 16384, t, 0, BANDTILE); \
        asm volatile("s_waitcnt vmcnt(0)" ::: "memory"); __syncthreads(); } while (0)
#define SETNMC(cbv) do { const float nv_ = nm_ref + (cbv); _Pragma("unroll") for (int r = 0; r < 16; ++r) nm[r] = nv_; } while (0)
    if (wid >= 4) __builtin_amdgcn_s_setprio(1);
    static_assert(RING == 2 || NK + 2 == 5, "counted wait assumes 5 loads per thread per tile");
    if constexpr (RING == 3) {
        DMA2(0, 0, 0); DMA2(1, SHM_K, SHM_V); asm volatile("s_waitcnt vmcnt(0) lgkmcnt(0)\n\ts_barrier" ::: "memory");
        for (int j = 0; j + 2 < NT; j += 3) { TILE3(0, j); TILE3(1, j + 1); TILE3(2, j + 2); }
        static_assert((NT - 1) % 3 == 0, "tail tile must map to buffer 0");
        TILE3(0, NT - 1);
    } else {
        DMA2(0, 0, 0); asm volatile("s_waitcnt vmcnt(0)" ::: "memory"); __syncthreads();
        int t = 0;
        if constexpr (BIAS) {
            const int nL = q0 >= 191 ? (q0 - 191) / KVBLK + 1 : 0, tR = (q0 + 383 + KVBLK - 1) / KVBLK;
            const int a = (nL / 2) * 2; int be = ((tR + 1) / 2) * 2; if (be > NT) be = NT;
            SETNMC(cb_lo);
            for (; t < a; t += 2) { TILEX(0, t, false); TILEX(1, t + 1, false); }
            SETNMC(0.f);
            for (; t < be; t += 2) { TILEX(0, t, true); TILEX(1, t + 1, true); }
            SETNMC(cb_hi);
        }
        for (; t < NT; t += 2) { TILEX(0, t, false); TILEX(1, t + 1, false); }
    }
#undef TILEC
#undef TILE3
#undef TILEX
#undef SETNMC
#undef PK4
    __builtin_amdgcn_s_setprio(0);
    if constexpr (KPERM) { auto rr = __builtin_amdgcn_permlane32_swap(__float_as_uint(l_reg), __float_as_uint(l_reg), false, false); l_reg = __uint_as_float(rr[0]) + __uint_as_float(rr[1]); }
    if (hi == 0) li_l[r32] = l_reg; asm volatile("s_waitcnt lgkmcnt(0)" ::: "memory");
#pragma unroll
    for (int r = 0; r < 16; ++r) { const float rl = __builtin_amdgcn_rcpf(li_l[crow(r, hi)]);
#pragma unroll
        for (int d = 0; d < 4; ++d) o[d][r] *= rl; }
#undef DMA2
}
}

__device__ __forceinline__ int t5_bucket(int rel) {
    const int n = rel < 0 ? -rel : rel; int b;
    if (n < 8) b = n; else if (n < 12) b = 8; else if (n < 16) b = 9; else if (n < 23) b = 10; else if (n < 32) b = 11; else if (n < 46) b = 12; else if (n < 64) b = 13; else if (n < 91) b = 14; else b = 15;
    return (rel > 0 ? 16 : 0) + b;
}
template <int KIND> __device__ __forceinline__ int dst_row(int n) {
    if constexpr (KIND == 1) { if (n < 3840) return n; const int d = n - 3840; return 3840 + (d < 32 ? 2 * d : 2 * (d - 32) + 1); }
    else if constexpr (KIND == 2) { const int h = n / 192, w = n - h * 192; if (w < 128) return n; const int d = w - 128; return h * 192 + 128 + (d < 32 ? 2 * d : 2 * (d - 32) + 1); }
    else if constexpr (KIND == 3) return 256 * (n >> 7) + (n & 127);
    else if constexpr (KIND == 4) return 256 * (n >> 7) + 128 + (n & 127);
    else return n;
}
template <int KIND>
__device__ __forceinline__ void transpose_item(const float* __restrict__ W, int K, int N, const float* __restrict__ g, bf16_t* __restrict__ WT, LAS float* scr, int item, int lane) {
    const int nblk = N / 32, kb = item / nblk, nb = item - kb * nblk, k0 = 64 * kb, n0 = 32 * nb;
#pragma unroll 8
    for (int i = 0; i < 32; ++i) { const int kk = 2 * i + (lane >> 5); float v = W[(size_t)(k0 + kk) * N + n0 + (lane & 31)]; if (g) v *= g[k0 + kk]; scr[kk * 33 + (lane & 31)] = v; }
    LDS_WAIT(); asm volatile("" ::: "memory");
    const int c = lane & 7;
#pragma unroll
    for (int j = 0; j < 4; ++j) { const int n = (lane >> 3) + 8 * j; const LAS float* s = scr + (8 * c) * 33 + n;
        u32x4 o; o.x = cvt_pk_bf16(s[0 * 33], s[1 * 33]); o.y = cvt_pk_bf16(s[2 * 33], s[3 * 33]); o.z = cvt_pk_bf16(s[4 * 33], s[5 * 33]); o.w = cvt_pk_bf16(s[6 * 33], s[7 * 33]);
        *(u32x4*)(WT + (size_t)dst_row<KIND>(n0 + n) * K + k0 + 8 * c) = o; }
    LDS_WAIT(); asm volatile("" ::: "memory");
}
__device__ __forceinline__ void rms_row_bf16(const float* __restrict__ xrow, const float* __restrict__ g, bf16_t* __restrict__ orow, int lane) {
    const f32x4* xr = (const f32x4*)xrow + lane; const f32x4* gr = (const f32x4*)g + lane;
    f32x4 v[8]; float s = 0.f;
#pragma unroll
    for (int j = 0; j < 8; ++j) { v[j] = xr[64 * j]; s += (v[j].x * v[j].x + v[j].y * v[j].y) + (v[j].z * v[j].z + v[j].w * v[j].w); }
    const float rstd = rsqrtf(wave_sum(s) * (1.f / DM) + EPS);
    u32x2* o8 = (u32x2*)orow + lane;
#pragma unroll
    for (int j = 0; j < 8; ++j) { const f32x4 gg = gr[64 * j]; u32x2 w; w.x = cvt_pk_bf16(v[j].x * rstd * gg.x, v[j].y * rstd * gg.y); w.y = cvt_pk_bf16(v[j].z * rstd * gg.z, v[j].w * rstd * gg.w); o8[64 * j] = w; }
}
__device__ __forceinline__ void rms_row_f32(float* xrow, const float* __restrict__ g, int lane) {
    f32x4* xr = (f32x4*)xrow + lane; const f32x4* gr = (const f32x4*)g + lane;
    f32x4 v[8]; float s = 0.f;
#pragma unroll
    for (int j = 0; j < 8; ++j) { v[j] = xr[64 * j]; s += (v[j].x * v[j].x + v[j].y * v[j].y) + (v[j].z * v[j].z + v[j].w * v[j].w); }
    const float rstd = rsqrtf(wave_sum(s) * (1.f / DM) + EPS);
#pragma unroll
    for (int j = 0; j < 8; ++j) xr[64 * j] = v[j] * rstd * gr[64 * j];
}

constexpr int LDS_BYTES = 147456;
struct Args { const float* in[19]; float* out; unsigned char* ws; int ph_lo, ph_hi; };

__global__ void __launch_bounds__(512, 2) fwd_mega(Args args) {
    extern __shared__ __attribute__((aligned(16))) unsigned char lds_raw[];
    LAS unsigned char* lds = (LAS unsigned char*)lds_raw;
    cg::grid_group grid = cg::this_grid();
    const int tid = threadIdx.x, lane = tid & 63, wave = __builtin_amdgcn_readfirstlane(tid >> 6);
    const int G = gridDim.x, bx = blockIdx.x;
    unsigned char* ws = args.ws;
    const float* x = args.in[0];
    bf16_t* Wt_uq = (bf16_t*)(ws + WS_WUQ); bf16_t* Wt_ukv = (bf16_t*)(ws + WS_WUKV); bf16_t* Wt_in = (bf16_t*)(ws + WS_WIN); bf16_t* Wt_out = (bf16_t*)(ws + WS_WOUT);
    bf16_t* Wt_gu = (bf16_t*)(ws + WS_WGU); bf16_t* Wt_dn = (bf16_t*)(ws + WS_WDN);
    bf16_t* HB = (bf16_t*)(ws + WS_HB); float* X1 = (float*)(ws + WS_X1); float* O1 = (float*)(ws + WS_O1);
    bf16_t* CQ = (bf16_t*)(ws + WS_CQ); bf16_t* CKV = (bf16_t*)(ws + WS_CKV); bf16_t* VB = (bf16_t*)(ws + WS_VB);
    bf16_t* QA = (bf16_t*)(ws + WS_QA); bf16_t* KA = (bf16_t*)(ws + WS_KA); bf16_t* VA = (bf16_t*)(ws + WS_VA); bf16_t* QB = (bf16_t*)(ws + WS_QB); bf16_t* KB = (bf16_t*)(ws + WS_KB);
    bf16_t* ACT = (bf16_t*)(ws + WS_ACT);
    float* LAM = (float*)(ws + WS_CTL); float* TBL = (float*)(ws + WS_TBL); float* SSQQ = (float*)(ws + WS_SSQQ); float* SSQKV = (float*)(ws + WS_SSQKV); float* SSQ2 = (float*)(ws + WS_SSQ2); bf16_t* H2 = (bf16_t*)args.out;
    float* COS = (float*)(ws + WS_COS); float* SIN = (float*)(ws + WS_SIN);
    const int lo = args.ph_lo, hi_ph = args.ph_hi;
#ifndef PH_MASK
#define PH_MASK 0x1ff
#endif
#define IN(k) (((PH_MASK >> (k)) & 1) && lo <= (k) && (k) < hi_ph)
#define SEAM(k) do { if (IN(k) && IN((k) + 1)) grid.sync(); } while (0)

    if (IN(0)) {
        LAS float* scr = (LAS float*)(lds + wave * 16384);
        const int gw = bx * 8 + wave, NGW = G * 8;
        constexpr int I_IN = (DM / 64) * (NIN / 32), I_UQ = (QLR / 64) * (NQB / 32), I_UKV = (KVLR / 64) * (NKV / 32), I_OUT = (DM / 64) * (DM / 32), I_G = (DM / 64) * (DFF / 32), I_DN = (DFF / 64) * (DM / 32);
        constexpr int NITEMS = I_IN + I_UQ + I_UKV + I_OUT + 2 * I_G + I_DN;
        for (int it = gw; it < NITEMS; it += NGW) {
            int r = it;
            if (r < I_IN) { transpose_item<1>(args.in[2], DM, NIN, nullptr, Wt_in, scr, r, lane); continue; } r -= I_IN;
            if (r < I_UQ) { transpose_item<2>(args.in[4], QLR, NQB, args.in[3], Wt_uq, scr, r, lane); continue; } r -= I_UQ;
            if (r < I_UKV) { transpose_item<0>(args.in[6], KVLR, NKV, args.in[5], Wt_ukv, scr, r, lane); continue; } r -= I_UKV;
            if (r < I_OUT) { transpose_item<0>(args.in[13], DM, DM, nullptr, Wt_out, scr, r, lane); continue; } r -= I_OUT;
            if (r < I_G) { transpose_item<3>(args.in[15], DM, DFF, args.in[14], Wt_gu, scr, r, lane); continue; } r -= I_G;
            if (r < I_G) { transpose_item<4>(args.in[16], DM, DFF, args.in[14], Wt_gu, scr, r, lane); continue; } r -= I_G;
            transpose_item<0>(args.in[17], DFF, DM, nullptr, Wt_dn, scr, r, lane);
        }
        for (int m = gw; m < S; m += NGW) rms_row_bf16(x + (size_t)m * DM, args.in[1], HB + (size_t)m * DM, lane);
        const int gt = bx * 512 + tid, NGT = G * 512;
        for (int i = gt; i < (NINP - NIN) * DM / 8; i += NGT) ((u32x4*)(Wt_in + (size_t)NIN * DM))[i] = (u32x4){0u, 0u, 0u, 0u};
        for (int i = gt; i < S; i += NGT) { SSQQ[i] = 0.f; SSQKV[i] = 0.f; SSQ2[i] = 0.f; }
        for (int i = gt; i < S * 32; i += NGT) { const int pos = i >> 5, f = i & 31; const float inv = powf(10000.f, -(float)f / 32.f); const float ang = (float)pos * inv; COS[i] = cosf(ang); SIN[i] = sinf(ang); }
        if (gt < 32) ((float*)(ws + WS_KMXA))[gt] = 0.f; else if (gt < 64) ((float*)(ws + WS_KMXB))[gt - 32] = 0.f; else if (gt < 66) ((float*)(ws + WS_KMXR))[gt - 64] = 0.f;
        else if (gt < 74) { const int h = gt - 66; float mx = -1e30f; for (int bk = 0; bk < 32; ++bk) mx = fmaxf(mx, args.in[12][bk * 8 + h]); ((float*)(ws + WS_TBLMAX))[h] = mx * LOG2E; }
        for (int i = gt; i < 8 * 257; i += NGT) { const int h = i / 257, idx = i - h * 257; TBL[i] = args.in[12][t5_bucket(idx - 128) * 8 + h] * LOG2E; }
        if (bx == 0 && wave == 0) { const float s1 = wave_sum(args.in[7][lane] * args.in[8][lane]), s2 = wave_sum(args.in[9][lane] * args.in[10][lane]);
            if (lane == 0) LAM[0] = expf(s1) - expf(s2) + 0.2f; }
        __syncthreads();
    }
    SEAM(0);
    if (IN(1)) {
        pg8::Gemm g{HB, Wt_in, S, NINP, DM}; pg8::StaticOrder So; So.init(S, NINP, G, bx);
        EpiIn E{ws};
        pg8::gemm_phase<EpiIn, pg8::StaticOrder, true, true>(lds, g, So, E);
    }
    SEAM(1);
    if (IN(2)) {
        { pg8::Gemm g{CQ, Wt_uq, S, NQB, QLR}; pg8::StaticOrder So; So.init(S, NQB, G, bx); EpiQB E{QB, SSQQ, COS, SIN};
          pg8::gemm_phase<EpiQB, pg8::StaticOrder, true, true>(lds, g, So, E); }
        { pg8::Gemm g{CKV, Wt_ukv, S, NKV, KVLR}; pg8::StaticOrder So; So.init(S, NKV, G, bx); EpiKV E{KB, VB, SSQKV, (unsigned*)(ws + WS_KMXB)};
          pg8::gemm_phase<EpiKV, pg8::StaticOrder, true, true>(lds, g, So, E); }
    }
    SEAM(2);
    if (IN(3)) {
        const int r32 = lane & 31, hi = lane >> 5;
        const float lam = __uint_as_float(__builtin_amdgcn_readfirstlane(__float_as_uint(LAM[0])));
        LAS float* tbl_l = (LAS float*)(lds + att::OFF_TBL);
        const float* KMXA = (const float*)(ws + WS_KMXA); const float* KMXB = (const float*)(ws + WS_KMXB); const float* KMXR = (const float*)(ws + WS_KMXR); const float* TBLMAX = (const float*)(ws + WS_TBLMAX);
        float* OXb = O1 + (size_t)bx * (2 * 256 * 128);
#ifndef REPA
#define REPA 1
#endif
#ifndef REPB
#define REPB 1
#endif
        for (int rep = 0; rep < REPA; ++rep)
        for (int it = 0; ; ++it) {
            const int u = bx + (it >> 1) * G, mp = it & 1; if (u >= 512) break;
            const int h = u & 7, q0 = (u >> 3) * 256;
            for (int i = tid; i < 257; i += 512) tbl_l[i] = TBL[h * 257 + i];
            const float cb_lo = __uint_as_float(__builtin_amdgcn_readfirstlane(__float_as_uint(TBL[h * 257]))), cb_hi = __uint_as_float(__builtin_amdgcn_readfirstlane(__float_as_uint(TBL[h * 257 + 256])));
            f32x16 o[4];
            const float kmx = sqrtf(__uint_as_float(__builtin_amdgcn_readfirstlane(__float_as_uint(KMXA[(h * 2 + mp) * 2] + KMXA[(h * 2 + mp) * 2 + 1])))), bmx = __uint_as_float(__builtin_amdgcn_readfirstlane(__float_as_uint(TBLMAX[h])));
            att::attn_f<64, true, 1024, 1024, 1024>(QA + (size_t)q0 * 1024 + h * 128 + mp * 64, KA + h * 128 + mp * 64, VA + h * 128, lds, q0, cb_lo, cb_hi, kmx, bmx, o);
            { float* OX = OXb + mp * (256 * 128) + (wave * 32) * 128 + r32;
#pragma unroll
                for (int r = 0; r < 16; ++r)
#pragma unroll
                    for (int d = 0; d < 4; ++d) OX[att::crow(r, hi) * 128 + d * 32] = o[d][r]; }
            if (mp == 1) {
                __threadfence(); __syncthreads();
                const f32x2 gs = *(const f32x2*)(args.in[11] + 2 * lane);
                for (int rr = wave; rr < 256; rr += 32) {
                    float v0[4], v1[4], ss[4];
#pragma unroll
                    for (int q = 0; q < 4; ++q) { const int row = rr + 8 * q;
                        const f32x2 a = *(const f32x2*)(OXb + row * 128 + 2 * lane), b = *(const f32x2*)(OXb + 256 * 128 + row * 128 + 2 * lane);
                        v0[q] = a.x - lam * b.x; v1[q] = a.y - lam * b.y; ss[q] = v0[q] * v0[q] + v1[q] * v1[q]; }
#pragma unroll
                    for (int o_ = 1; o_ < 64; o_ <<= 1)
#pragma unroll
                        for (int q = 0; q < 4; ++q) ss[q] += __shfl_xor(ss[q], o_);
#pragma unroll
                    for (int q = 0; q < 4; ++q) { const float rstd = rsqrtf(ss[q] * (1.f / 128.f) + EPS) * 0.8f;
                        *(unsigned*)(HB + (size_t)(q0 + rr + 8 * q) * DM + h * 128 + 2 * lane) = cvt_pk_bf16(v0[q] * rstd * gs.x, v1[q] * rstd * gs.y); }
                }
                __syncthreads();
            }
        }
        for (int rep = 0; rep < REPB; ++rep)
        for (int u = bx; u < 512; u += G) {
            const int h = u & 7, q0 = (u >> 3) * 256;
            f32x16 o[4];
            const float kmx = sqrtf(__uint_as_float(__builtin_amdgcn_readfirstlane(__float_as_uint((KMXB[h * 4] + KMXB[h * 4 + 1]) + (KMXB[h * 4 + 2] + KMXB[h * 4 + 3]) + (KMXR[0] + KMXR[1])))));
            att::attn_f<192, false, NQB, NQB, 1024>(QB + (size_t)q0 * NQB + h * 192, KB + h * 192, VB + h * 128, lds, q0, 0.f, 0.f, kmx, 0.f, o);
            bf16_t* mix = HB + (size_t)(q0 + wave * 32) * DM + 1024 + h * 128 + r32;
#pragma unroll
            for (int r = 0; r < 16; ++r)
#pragma unroll
                for (int d = 0; d < 4; ++d) mix[(size_t)att::crow(r, hi) * DM + d * 32] = (bf16_t)(cvt_pk_bf16(o[d][r], 0.f) & 0xffffu);
        }
        __syncthreads();
    }
    SEAM(3);
    if (IN(4)) {
        pg8::Gemm g{HB, Wt_out, S, DM, DM}; pg8::StaticOrder So; So.init(S, DM, G, bx); EpiResH E{x, X1, H2, SSQ2};
        pg8::gemm_phase<EpiResH, pg8::StaticOrder, true, true>(lds, g, So, E);
    }
    SEAM(4);
    if (IN(6)) {
        pg8::Gemm g{H2, Wt_gu, S, NGU, DM}; pg8::StaticOrder So; So.init(S, NGU, G, bx); EpiGU E{ACT, SSQ2};
#ifndef REP6
#define REP6 1
#endif
        for (int rep = 0; rep < REP6; ++rep)
        pg8::gemm_phase<EpiGU, pg8::StaticOrder, true, true>(lds, g, So, E);
    }
    SEAM(6);
    if (IN(7)) {
        pg8::Gemm g{ACT, Wt_dn, S, DM, DFF}; pg8::StaticOrder So; So.init(S, DM, G, bx); EpiRes E{X1, args.out};
        pg8::gemm_phase<EpiRes, pg8::StaticOrder, true, true>(lds, g, So, E);
    }
    SEAM(7);
    if (IN(8)) {
        const int gw = bx * 8 + wave, NGW = G * 8;
        for (int m = gw; m < S; m += NGW) rms_row_f32(args.out + (size_t)m * DM, args.in[18], lane);
    }
#undef IN
#undef SEAM
}

extern "C" void kernel_launch(void* const* d_in, const int* in_sizes, int n_in, void* d_out, int out_size, void* d_ws, size_t ws_size, hipStream_t stream) {
    static int grid = 0;
    if (grid == 0) {
        if (n_in != 19 || in_sizes[0] != S * DM || out_size != S * DM || ws_size < WS_END) {
            fprintf(stderr, "kernel_launch: shape/workspace mismatch: n_in %d in0 %d out %d ws %zu (need %zu)\n", n_in, n_in > 0 ? in_sizes[0] : -1, out_size, ws_size, (size_t)WS_END); grid = -1; return; }
        int dev = 0, cus = 0, per_cu = 0;
        (void)hipGetDevice(&dev); (void)hipDeviceGetAttribute(&cus, hipDeviceAttributeMultiprocessorCount, dev);
        if (hipFuncSetAttribute((const void*)fwd_mega, hipFuncAttributeMaxDynamicSharedMemorySize, LDS_BYTES) != hipSuccess) { fprintf(stderr, "kernel_launch: hipFuncSetAttribute failed\n"); grid = -1; return; }
        if (hipOccupancyMaxActiveBlocksPerMultiprocessor(&per_cu, (const void*)fwd_mega, 512, LDS_BYTES) != hipSuccess || per_cu < 1) { fprintf(stderr, "kernel_launch: occupancy query says %d\n", per_cu); per_cu = 1; }
        (void)hipGetLastError();
        grid = cus < 256 ? cus : 256;
    }
    if (grid < 0) return;
    Args a{};
    for (int i = 0; i < 19; ++i) a.in[i] = (const float*)d_in[i];
    a.out = (float*)d_out; a.ws = (unsigned char*)d_ws;
#if MK_N_LAUNCHES == 1
    a.ph_lo = 0; a.ph_hi = NPHASE;
    void* kargs[] = {&a};
    hipError_t e = hipLaunchCooperativeKernel((const void*)fwd_mega, dim3(grid), dim3(512), kargs, LDS_BYTES, stream);
    if (e != hipSuccess) fprintf(stderr, "kernel_launch: cooperative launch failed: %s (grid %d)\n", hipGetErrorString(e), grid);
#else
    for (int p = 0; p < NPHASE; ++p) { a.ph_lo = p; a.ph_hi = p + 1; hipLaunchKernelGGL(fwd_mega, dim3(grid), dim3(512), LDS_BYTES, stream, a); }
#endif
}
```

```cpp
#define NO_SBAR 1
#include <hip/hip_runtime.h>
#include <hip/hip_cooperative_groups.h>
#include <cstdio>
#include <cstdint>
namespace cg = cooperative_groups;

#ifndef MK_N_LAUNCHES
#define MK_N_LAUNCHES 1
#endif

#define LAS __attribute__((address_space(3)))
typedef unsigned short bf16_t;
typedef short bf16x8 __attribute__((ext_vector_type(8)));
typedef short s16x4 __attribute__((ext_vector_type(4)));
typedef float f32x4 __attribute__((ext_vector_type(4)));
typedef float f32x2 __attribute__((ext_vector_type(2)));
typedef float f32x16 __attribute__((ext_vector_type(16)));
typedef unsigned u32x4 __attribute__((ext_vector_type(4)));
typedef unsigned u32x2 __attribute__((ext_vector_type(2)));

constexpr int S = 16384, DM = 2048, NIN = 3904, NINP = 4096, DFF = 5632, NGU = 2 * DFF;
constexpr int QLR = 512, KVLR = 256, NQB = 1536, NKV = 2048;
constexpr float EPS = 1e-6f, LOG2E = 1.4426950408889634f;
constexpr int NPHASE = 9;

constexpr size_t MiB = 1u << 20;
constexpr size_t WS_CTL = 0;
constexpr size_t WS_TBL = 4096, WS_SSQQ = 65536, WS_SSQKV = 131072, WS_KMXA = 256, WS_KMXB = 384, WS_TBLMAX = 512, WS_KMXR = 640;
constexpr size_t WS_COS = 1 * MiB, WS_SIN = 3 * MiB;
constexpr size_t WS_WUQ = 5 * MiB, WS_WUKV = 7 * MiB, WS_WIN = 8 * MiB, WS_WOUT = 24 * MiB, WS_WGU = 32 * MiB, WS_WDN = 76 * MiB;
constexpr size_t WS_HB = 98 * MiB;
constexpr size_t WS_X1 = 162 * MiB;
constexpr size_t WS_O1 = WS_X1, WS_CQ = WS_X1 + 64 * MiB, WS_CKV = WS_X1 + 80 * MiB, WS_VB = WS_X1 + 88 * MiB;
constexpr size_t WS_R = 290 * MiB;
constexpr size_t WS_QA = WS_R, WS_KA = WS_R + 32 * MiB, WS_VA = WS_R + 64 * MiB, WS_QB = WS_R + 96 * MiB, WS_KB = WS_R + 144 * MiB;
constexpr size_t WS_ACT = WS_R;
constexpr size_t WS_END = WS_R + 192 * MiB;

__device__ __forceinline__ unsigned cvt_pk_bf16(float lo, float hi) { unsigned r; asm volatile("v_cvt_pk_bf16_f32 %0, %1, %2" : "=v"(r) : "v"(lo), "v"(hi)); return r; }
__device__ __forceinline__ float wave_sum(float v) {
#pragma unroll
    for (int o = 1; o < 64; o <<= 1) v += __shfl_xor(v, o);
    return v;
}
#define LDS_WAIT() asm volatile("s_waitcnt lgkmcnt(0)" ::: "memory")

namespace pg8 {
constexpr int BM = 256, BK = 64, HALF = 128, HTB = HALF * BK * 2, STAGE_BYTES = 8 * HTB, NXCD = 8, WGM = 8;
__host__ __device__ __forceinline__ int lds_byte(int r, int c) { const int st = (r >> 4) * 2 + (c >> 5), rr = r & 15, cc = c & 31, ob = rr * 64 + cc * 2; return st * 1024 + (ob ^ (((ob >> 9) & 1) << 5)); }
__host__ __device__ __forceinline__ void stage_rc(int b, int& R, int& C) { const int st = b / 1024, sb = b % 1024, swz = sb ^ (((sb >> 9) & 1) << 5); R = (st >> 1) * 16 + swz / 64; C = (st & 1) * 32 + (swz % 64) / 2; }
__host__ __device__ __forceinline__ int perm32(int rho) { const int n = rho >> 4, i = rho & 15; return 8 * (i >> 2) + 4 * n + (i & 3); }
struct Unit { int pm, pn; };
struct Gemm { const bf16_t* A; const bf16_t* Bt; int M, N, K; };
struct StaticOrder {
    int nM, nN, nwg, G, c;
    __host__ __device__ void init(int M, int N, int G_, int c_) { nM = M / BM; nN = N / BM; nwg = nM * nN; G = G_; c = c_; }
    __host__ __device__ bool next(int i, Unit& u) const {
        const long L = (long)i * G + c; if (L >= nwg) return false;
        int wgid = (int)L; { const int q = nwg / NXCD, r = nwg % NXCD, xcd = wgid % NXCD, off = wgid / NXCD; wgid = (xcd < r ? xcd * (q + 1) : r * (q + 1) + (xcd - r) * q) + off; }
        const int nig = WGM * nN, gid = wgid / nig, fm = gid * WGM, gsz = (nM - fm) < WGM ? (nM - fm) : WGM;
        u.pm = fm + ((wgid % nig) % gsz); u.pn = (wgid % nig) / gsz; return true;
    }
    __device__ __forceinline__ void a_ready(const Unit&) const {}
    __device__ __forceinline__ void done(const Unit&) const {}
};
template <class Epi, class Sched, bool ALIGN_EPI = false, bool SP2 = false>
__device__ __forceinline__ void gemm_phase(LAS unsigned char* lds, const Gemm g, const Sched& Sd, const Epi& E) {
    int tid_ = threadIdx.x; asm volatile("" : "+v"(tid_));
    const int tid = tid_, wid = __builtin_amdgcn_readfirstlane(tid >> 6), lane = tid & 63, wr = wid >> 2, wc = wid & 3, fr = lane & 15, fq = lane >> 4;
    const int K = g.K, nt = K / BK;
    unsigned voffA[2], voffB[2];
#pragma unroll
    for (int i = 0; i < 2; ++i) { int R, C; stage_rc(tid * 16 + i * 8192, R, C); const int Rb = Epi::PERM ? ((R & ~31) + perm32(R & 31)) : R;
        voffA[i] = (unsigned)(R * K + C) * 2u; voffB[i] = (unsigned)(Rb * K + C) * 2u; }
    const size_t kstep = (size_t)(BK * 2);
    const size_t hstep = (size_t)HALF * K * 2;
    const size_t tstep = 2 * hstep;
    const unsigned ldsw = (unsigned)wid * 1024u;
    const int aoff = lds_byte(wr * 64 + fr, fq * 8), boff = lds_byte(wc * 32 + fr, fq * 8);
#define PG8_SA(b, h) (((b) * 2 + (h)) * HTB)
#define PG8_SB(b, h) ((4 + (b) * 2 + (h)) * HTB)
#define PG8_STAGE(bufoff, gbase, voff) do { _Pragma("unroll") for (int _i = 0; _i < 2; ++_i) \
        __builtin_amdgcn_global_load_lds((const unsigned*)((const char*)(gbase) + (voff)[_i]), (LAS unsigned*)(lds + (bufoff) + ldsw + _i * 8192), 16, 0, 0); } while (0)
#define PG8_LDA(dst, b, h) do { _Pragma("unroll") for (int m = 0; m < 4; ++m) _Pragma("unroll") for (int k = 0; k < 2; ++k) dst[m][k] = *(const LAS bf16x8*)(lds + PG8_SA(b, h) + aoff + m * 2048 + k * 1024); } while (0)
#define PG8_LDB(dst, b, h) do { _Pragma("unroll") for (int n = 0; n < 2; ++n) _Pragma("unroll") for (int k = 0; k < 2; ++k) dst[n][k] = *(const LAS bf16x8*)(lds + PG8_SB(b, h) + boff + n * 2048 + k * 1024); } while (0)
#define PG8_MMA(ai, bj, At, Bt) do { __builtin_amdgcn_s_setprio(1); _Pragma("unroll") for (int m = 0; m < 4; ++m) _Pragma("unroll") for (int n = 0; n < 2; ++n) _Pragma("unroll") for (int k = 0; k < 2; ++k) \
        acc[ai][bj][m][n] = __builtin_amdgcn_mfma_f32_16x16x32_bf16(Bt[n][k], At[m][k], acc[ai][bj][m][n], 0, 0, 0); __builtin_amdgcn_s_setprio(0); } while (0)
#define PG8_WAIT_V(n) asm volatile("s_waitcnt vmcnt(" #n ")" ::: "memory")
#define PG8_WAIT_L(n) asm volatile("s_waitcnt lgkmcnt(" #n ")" ::: "memory")
#define PG8_BAR __builtin_amdgcn_s_barrier()
#define PG8_SCHED __builtin_amdgcn_sched_barrier(0)
    Unit cur, nxt; int ui = 0;
    if (!Sd.next(0, cur)) return;
    f32x4 acc[2][2][4][2];
#pragma unroll
    for (int a = 0; a < 2; ++a)
#pragma unroll
        for (int b = 0; b < 2; ++b)
#pragma unroll
            for (int m = 0; m < 4; ++m)
#pragma unroll
                for (int n = 0; n < 2; ++n) acc[a][b][m][n] = (f32x4){0.f, 0.f, 0.f, 0.f};
    bf16x8 At[4][2], B0[2][2], B1[2][2];
    const char* cA = (const char*)g.A + (size_t)cur.pm * tstep; const char* cB = (const char*)g.Bt + (size_t)cur.pn * tstep;
    Sd.a_ready(cur);
    if constexpr (SP2) {
        PG8_STAGE(PG8_SB(0, 0), cB, voffB); PG8_STAGE(PG8_SB(0, 1), cB + hstep, voffB); PG8_STAGE(PG8_SA(0, 0), cA, voffA); PG8_STAGE(PG8_SA(0, 1), cA + hstep, voffA);
        if (wr == 1) PG8_BAR;
        PG8_WAIT_V(2); PG8_BAR;
        PG8_STAGE(PG8_SB(1, 0), cB + kstep, voffB); PG8_STAGE(PG8_SA(1, 0), cA + kstep, voffA); PG8_STAGE(PG8_SB(1, 1), cB + hstep + kstep, voffB);
        PG8_WAIT_V(6); PG8_BAR;
    } else {
        PG8_STAGE(PG8_SB(0, 0), cB, voffB); PG8_STAGE(PG8_SA(0, 0), cA, voffA); PG8_STAGE(PG8_SB(0, 1), cB + hstep, voffB); PG8_STAGE(PG8_SA(0, 1), cA + hstep, voffA);
        if (wr == 1) PG8_BAR;
        PG8_WAIT_V(4); PG8_BAR;
        PG8_STAGE(PG8_SB(1, 0), cB + kstep, voffB); PG8_STAGE(PG8_SA(1, 0), cA + kstep, voffA); PG8_STAGE(PG8_SB(1, 1), cB + hstep + kstep, voffB);
        PG8_WAIT_V(6); PG8_BAR;
    }
    for (;;) {
        const bool has_next = Sd.next(ui + 1, nxt);
        const char* nA = has_next ? (const char*)g.A + (size_t)nxt.pm * tstep : cA; const char* nB = has_next ? (const char*)g.Bt + (size_t)nxt.pn * tstep : cB;
        for (int t = 0; t < nt; t += 2) {
            const bool last = (t == nt - 2);
            const char* a1 = cA + (size_t)(t + 1) * kstep;
            const char* a2 = last ? nA : cA + (size_t)(t + 2) * kstep; const char* b2 = last ? nB : cB + (size_t)(t + 2) * kstep;
            const char* a3 = a2 + kstep; const char* b3 = b2 + kstep;
            if (last && has_next) Sd.a_ready(nxt);
            if constexpr (SP2) {
            PG8_LDB(B0, 0, 0); PG8_LDB(B1, 0, 1); PG8_SCHED; PG8_LDA(At, 0, 0); PG8_STAGE(PG8_SA(1, 1), a1 + hstep, voffA);
            PG8_WAIT_V(8); PG8_WAIT_L(0); PG8_BAR; PG8_MMA(0, 0, At, B0); PG8_MMA(0, 1, At, B1); PG8_BAR; PG8_SCHED;
            PG8_LDA(At, 0, 1); PG8_STAGE(PG8_SB(0, 0), b2, voffB); PG8_STAGE(PG8_SB(0, 1), b2 + hstep, voffB); PG8_STAGE(PG8_SA(0, 0), a2, voffA);
            PG8_WAIT_V(8); PG8_WAIT_L(0); PG8_BAR; PG8_MMA(1, 0, At, B0); PG8_MMA(1, 1, At, B1); PG8_BAR; PG8_SCHED;
            PG8_LDB(B0, 1, 0); PG8_LDB(B1, 1, 1); PG8_SCHED; PG8_LDA(At, 1, 0); PG8_STAGE(PG8_SA(0, 1), a2 + hstep, voffA);
            PG8_WAIT_V(8); PG8_WAIT_L(0); PG8_BAR; PG8_MMA(0, 0, At, B0); PG8_MMA(0, 1, At, B1); PG8_BAR; PG8_SCHED;
            PG8_LDA(At, 1, 1); PG8_STAGE(PG8_SB(1, 0), b3, voffB); PG8_STAGE(PG8_SB(1, 1), b3 + hstep, voffB); PG8_STAGE(PG8_SA(1, 0), a3, voffA);
            PG8_WAIT_V(8); PG8_WAIT_L(0); PG8_BAR; PG8_MMA(1, 0, At, B0); PG8_MMA(1, 1, At, B1); PG8_BAR; PG8_SCHED;
            } else {
            PG8_LDB(B0, 0, 0); PG8_SCHED; PG8_LDA(At, 0, 0); PG8_STAGE(PG8_SA(1, 1), a1 + hstep, voffA);
            PG8_WAIT_L(8); PG8_BAR; PG8_WAIT_L(0); PG8_MMA(0, 0, At, B0); PG8_BAR; PG8_SCHED;
            PG8_LDB(B1, 0, 1); PG8_STAGE(PG8_SB(0, 0), b2, voffB);
            PG8_BAR; PG8_WAIT_L(0); PG8_MMA(0, 1, At, B1); PG8_BAR;
            PG8_LDA(At, 0, 1); PG8_STAGE(PG8_SA(0, 0), a2, voffA);
            PG8_BAR; PG8_WAIT_L(0); PG8_MMA(1, 0, At, B0); PG8_BAR; PG8_SCHED;
            PG8_STAGE(PG8_SB(0, 1), b2 + hstep, voffB);
            PG8_WAIT_V(6); PG8_BAR; PG8_MMA(1, 1, At, B1); PG8_BAR;
            PG8_LDB(B0, 1, 0); PG8_SCHED; PG8_LDA(At, 1, 0); PG8_STAGE(PG8_SA(0, 1), a2 + hstep, voffA);
            PG8_WAIT_L(8); PG8_BAR; PG8_WAIT_L(0); PG8_MMA(0, 0, At, B0); PG8_BAR; PG8_SCHED;
            PG8_LDB(B1, 1, 1); PG8_STAGE(PG8_SB(1, 0), b3, voffB);
            PG8_BAR; PG8_WAIT_L(0); PG8_MMA(0, 1, At, B1); PG8_BAR;
            PG8_LDA(At, 1, 1); PG8_STAGE(PG8_SA(1, 0), a3, voffA);
            PG8_BAR; PG8_WAIT_L(0); PG8_MMA(1, 0, At, B0); PG8_BAR; PG8_SCHED;
            PG8_STAGE(PG8_SB(1, 1), b3 + hstep, voffB);
            PG8_WAIT_V(6); PG8_BAR; PG8_MMA(1, 1, At, B1); PG8_BAR;
            }
        }
        if constexpr (ALIGN_EPI) { if (wr == 0) PG8_BAR; }
        E(acc, cur, wr, wc, fr, fq); Sd.done(cur);
        if (!has_next) break;
#pragma unroll
        for (int a = 0; a < 2; ++a)
#pragma unroll
            for (int b = 0; b < 2; ++b)
#pragma unroll
                for (int m = 0; m < 4; ++m)
#pragma unroll
                    for (int n = 0; n < 2; ++n) acc[a][b][m][n] = (f32x4){0.f, 0.f, 0.f, 0.f};
        cur = nxt; cA = nA; cB = nB; ++ui;
        if constexpr (ALIGN_EPI) { if (wr == 1) PG8_BAR; }
    }
    PG8_WAIT_V(0);
    if constexpr (!ALIGN_EPI) { if (wr == 0) PG8_BAR; }
    PG8_BAR;
#undef PG8_SA
#undef PG8_SB
#undef PG8_STAGE
#undef PG8_LDA
#undef PG8_LDB
#undef PG8_MMA
#undef PG8_WAIT_V
#undef PG8_WAIT_L
#undef PG8_BAR
#undef PG8_SCHED
}
}

using pg8::Unit;
__device__ __forceinline__ u32x4 pack8(f32x4 a, f32x4 b) { u32x4 w; w.x = cvt_pk_bf16(a[0], a[1]); w.y = cvt_pk_bf16(a[2], a[3]); w.z = cvt_pk_bf16(b[0], b[1]); w.w = cvt_pk_bf16(b[2], b[3]); return w; }
__device__ __forceinline__ void rope8(f32x4& v0, f32x4& v1, f32x4 cs, f32x4 sn) {
    f32x4 a = v0, b = v1;
    v0[0] = a[0] * cs[0] - a[1] * sn[0]; v0[1] = a[1] * cs[0] + a[0] * sn[0];
    v0[2] = a[2] * cs[1] - a[3] * sn[1]; v0[3] = a[3] * cs[1] + a[2] * sn[1];
    v1[0] = b[0] * cs[2] - b[1] * sn[2]; v1[1] = b[1] * cs[2] + b[0] * sn[2];
    v1[2] = b[2] * cs[3] - b[3] * sn[3]; v1[3] = b[3] * cs[3] + b[2] * sn[3];
}
__device__ __forceinline__ float fr_max(float v) { v = fmaxf(v, __shfl_xor(v, 1)); v = fmaxf(v, __shfl_xor(v, 2)); v = fmaxf(v, __shfl_xor(v, 4)); v = fmaxf(v, __shfl_xor(v, 8)); return v; }
__device__ __forceinline__ float sq8f(f32x4 a, f32x4 b) { return (a[0] * a[0] + a[1] * a[1]) + (a[2] * a[2] + a[3] * a[3]) + (b[0] * b[0] + b[1] * b[1]) + (b[2] * b[2] + b[3] * b[3]); }
struct EpiIn {
    static constexpr bool PERM = true;
    unsigned char* ws;
    __device__ __forceinline__ void operator()(const f32x4 (&acc)[2][2][4][2], const Unit& u, int wr, int wc, int fr, int fq) const {
        const int row0 = u.pm * 256 + wr * 64 + fr, pn = u.pn, cl = wc * 32 + 8 * fq;
        bf16_t* KB = (bf16_t*)(ws + WS_KB); const float* COS = (const float*)(ws + WS_COS); const float* SIN = (const float*)(ws + WS_SIN);
        if (pn < 12) {
            bf16_t* base = (bf16_t*)(ws + WS_QA + (size_t)(pn >> 2) * (32 * MiB)); const int colt = (pn & 3) * 256 + cl; const float qsc = pn < 4 ? 0.125f * LOG2E : 1.f;
#pragma unroll
            for (int ai = 0; ai < 2; ++ai)
#pragma unroll
                for (int m = 0; m < 4; ++m) { bf16_t* rowp = base + (size_t)(row0 + ai * 128 + m * 16) * 1024 + colt;
#pragma unroll
                    for (int bj = 0; bj < 2; ++bj) *(u32x4*)(rowp + bj * 128) = pack8(acc[ai][bj][m][0] * qsc, acc[ai][bj][m][1] * qsc); }
            if (pn >= 4 && pn < 8) {
                float mx[2] = {0.f, 0.f};
#pragma unroll
                for (int ai = 0; ai < 2; ++ai)
#pragma unroll
                    for (int m = 0; m < 4; ++m)
#pragma unroll
                        for (int bj = 0; bj < 2; ++bj) { float q = sq8f(acc[ai][bj][m][0], acc[ai][bj][m][1]); q += __shfl_xor(q, 16); q += __shfl_xor(q, 32); mx[bj] = fmaxf(mx[bj], q); }
#pragma unroll
                for (int bj = 0; bj < 2; ++bj) { const float v = fr_max(mx[bj]); if (fr == 0 && fq == 0) atomicMax((unsigned*)(ws + WS_KMXA) + ((2 * (pn - 4) + bj) * 2 + (wc >> 1)) * 2 + (wc & 1), __float_as_uint(v)); }
            }
        } else if (pn < 15) {
            const bool isq = pn < 14; bf16_t* base = (bf16_t*)(ws + (isq ? WS_CQ : WS_CKV)); const int ld = isq ? QLR : KVLR, colt = isq ? (pn - 12) * 256 + cl : cl; float* ssq = (float*)(ws + (isq ? WS_SSQQ : WS_SSQKV));
#pragma unroll
            for (int ai = 0; ai < 2; ++ai)
#pragma unroll
                for (int m = 0; m < 4; ++m) { const int row = row0 + ai * 128 + m * 16; bf16_t* rowp = base + (size_t)row * ld + colt; float s = 0.f;
#pragma unroll
                    for (int bj = 0; bj < 2; ++bj) { const f32x4 a = acc[ai][bj][m][0], b = acc[ai][bj][m][1];
                        s += (a[0] * a[0] + a[1] * a[1]) + (a[2] * a[2] + a[3] * a[3]) + (b[0] * b[0] + b[1] * b[1]) + (b[2] * b[2] + b[3] * b[3]);
                        *(u32x4*)(rowp + bj * 128) = pack8(a, b); }
                    s += __shfl_xor(s, 16); s += __shfl_xor(s, 32);
                    if (fq == 0) atomicAdd(ssq + row, s); }
        } else {
            if (wc < 2) {
#pragma unroll
                for (int ai = 0; ai < 2; ++ai)
#pragma unroll
                    for (int m = 0; m < 4; ++m) { const int row = row0 + ai * 128 + m * 16; const int i0 = cl >> 1;
                        const f32x4 cs = *(const f32x4*)(COS + (size_t)row * 32 + i0), sn = *(const f32x4*)(SIN + (size_t)row * 32 + i0);
                        f32x4 a = acc[ai][0][m][0], b = acc[ai][0][m][1]; rope8(a, b, cs, sn); const u32x4 w = pack8(a, b);
                        bf16_t* rowp = KB + (size_t)row * NQB + 128 + cl;
#pragma unroll
                        for (int h = 0; h < 8; ++h) *(u32x4*)(rowp + h * 192) = w; }
                float mxr = 0.f;
#pragma unroll
                for (int ai = 0; ai < 2; ++ai)
#pragma unroll
                    for (int m = 0; m < 4; ++m) { float q = sq8f(acc[ai][0][m][0], acc[ai][0][m][1]); q += __shfl_xor(q, 16); q += __shfl_xor(q, 32); mxr = fmaxf(mxr, q); }
                mxr = fr_max(mxr); if (fr == 0 && fq == 0) atomicMax((unsigned*)(ws + WS_KMXR) + wc, __float_as_uint(mxr));
            }
        }
    }
};
struct EpiQB {
    static constexpr bool PERM = true;
    bf16_t* QB; const float *SSQ, *COS, *SIN;
    __device__ __forceinline__ void operator()(const f32x4 (&acc)[2][2][4][2], const Unit& u, int wr, int wc, int fr, int fq) const {
        const int row0 = u.pm * 256 + wr * 64 + fr;
#pragma unroll
        for (int ai = 0; ai < 2; ++ai)
#pragma unroll
            for (int m = 0; m < 4; ++m) { const int row = row0 + ai * 128 + m * 16; const float rstd = rsqrtf(SSQ[row] * (1.f / QLR) + EPS) * (0.07216878364870322f * LOG2E);
#pragma unroll
                for (int bj = 0; bj < 2; ++bj) { const int colw = u.pn * 256 + bj * 128 + wc * 32, hw = colw / 192, w = colw - hw * 192, col = colw + 8 * fq;
                    f32x4 a = acc[ai][bj][m][0] * rstd, b = acc[ai][bj][m][1] * rstd;
                    if (w >= 128) { const int i0 = ((w - 128) >> 1) + 4 * fq;
                        const f32x4 cs = *(const f32x4*)(COS + (size_t)row * 32 + i0), sn = *(const f32x4*)(SIN + (size_t)row * 32 + i0); rope8(a, b, cs, sn); }
                    *(u32x4*)(QB + (size_t)row * NQB + col) = pack8(a, b); } }
    }
};
struct EpiKV {
    static constexpr bool PERM = true;
    bf16_t *KB, *VB; const float* SSQ; unsigned* KMX;
    __device__ __forceinline__ void operator()(const f32x4 (&acc)[2][2][4][2], const Unit& u, int wr, int wc, int fr, int fq) const {
        const int row0 = u.pm * 256 + wr * 64 + fr, h = u.pn, cl = wc * 32 + 8 * fq; float mx = 0.f;
#pragma unroll
        for (int ai = 0; ai < 2; ++ai)
#pragma unroll
            for (int m = 0; m < 4; ++m) { const int row = row0 + ai * 128 + m * 16; const float rstd = rsqrtf(SSQ[row] * (1.f / KVLR) + EPS);
                { float q = sq8f(acc[ai][0][m][0] * rstd, acc[ai][0][m][1] * rstd); q += __shfl_xor(q, 16); q += __shfl_xor(q, 32); mx = fmaxf(mx, q); }
                *(u32x4*)(KB + (size_t)row * NQB + h * 192 + cl) = pack8(acc[ai][0][m][0] * rstd, acc[ai][0][m][1] * rstd);
                *(u32x4*)(VB + (size_t)row * 1024 + h * 128 + cl) = pack8(acc[ai][1][m][0] * rstd, acc[ai][1][m][1] * rstd); }
        mx = fr_max(mx); if (fr == 0 && fq == 0) atomicMax(KMX + h * 4 + wc, __float_as_uint(mx));
    }
};
struct EpiRes {
    static constexpr bool PERM = false;
    const float* base; float* out;
    __device__ __forceinline__ void operator()(const f32x4 (&acc)[2][2][4][2], const Unit& u, int wr, int wc, int fr, int fq) const {
        const int row0 = u.pm * 256 + wr * 64 + fr, col0 = u.pn * 256 + wc * 32 + 4 * fq;
#pragma unroll
        for (int ai = 0; ai < 2; ++ai)
#pragma unroll
            for (int m = 0; m < 4; ++m) { const size_t off = (size_t)(row0 + ai * 128 + m * 16) * DM + col0;
#pragma unroll
                for (int bj = 0; bj < 2; ++bj)
#pragma unroll
                    for (int n = 0; n < 2; ++n) { const f32x4 bs = *(const f32x4*)(base + off + bj * 128 + n * 16); *(f32x4*)(out + off + bj * 128 + n * 16) = bs + acc[ai][bj][m][n]; } }
    }
};
struct EpiGU {
    static constexpr bool PERM = true;
    bf16_t* ACT;
    __device__ __forceinline__ void operator()(const f32x4 (&acc)[2][2][4][2], const Unit& u, int wr, int wc, int fr, int fq) const {
        const int row0 = u.pm * 256 + wr * 64 + fr, col = u.pn * 128 + wc * 32 + 8 * fq;
#pragma unroll
        for (int ai = 0; ai < 2; ++ai)
#pragma unroll
            for (int m = 0; m < 4; ++m) { f32x4 r[2];
#pragma unroll
                for (int n = 0; n < 2; ++n) { const f32x4 g = acc[ai][0][m][n], up = acc[ai][1][m][n];
#pragma unroll
                    for (int j = 0; j < 4; ++j) r[n][j] = g[j] * up[j] * __builtin_amdgcn_rcpf(1.f + __builtin_amdgcn_exp2f(-g[j] * LOG2E)); }
                *(u32x4*)(ACT + (size_t)(row0 + ai * 128 + m * 16) * DFF + col) = pack8(r[0], r[1]); }
    }
};

namespace att {
constexpr int NW = 8, QBLK = 32, KVBLK = 64;
constexpr float THR2 = 8.f * LOG2E;
constexpr int SHM_V = KVBLK * 128 * 2;
constexpr int OFF_K = 2 * SHM_V, OFF_WS = OFF_K + 2 * 64 * 192 * 2, OFF_TBL = OFF_WS + NW * 256, OFF_QL = OFF_TBL + 2048, ATT_LDS = OFF_QL + NW * 8192;
constexpr int OFF_KA = 65536, OFF_WSA = 98304, OFF_TBLA = 100352;
constexpr int OFF_K3 = 3 * SHM_V, OFF_WS3 = OFF_K3 + 3 * 24576, OFF_TBL3 = OFF_WS3 + NW * 256;
#ifdef NO_SBAR
#define SBAR() do {} while (0)
#else
#define SBAR() __builtin_amdgcn_sched_barrier(0)
#endif
__device__ __forceinline__ int crow(int r, int hi) { return (r & 3) + 8 * (r >> 2) + 4 * hi; }
template <int DQK> __device__ __forceinline__ int koff(int row, int c) { const int s = ((row >> 1) & 1) | (((row >> 3) & 3) << 1); return row * (DQK * 2) + ((c ^ s) << 4); }
__device__ __forceinline__ int v_st(int k, int c) { const int kk = (k & ~0xC) | ((k & 4) << 1) | ((k & 8) >> 1); return ((kk >> 3) * 4 + (c >> 5)) * 512 + ((kk & 7) * 32 + (c & 31)) * 2; }
__device__ __forceinline__ int v_rd_base(int lane) { return ((lane & 3) << 3) | (((lane >> 2) & 3) << 6) | (((lane >> 4) & 1) << 5) | (((lane >> 5) & 1) << 8); }
constexpr int v_rd_off(int d0, int ks, int half) { return d0 * 512 + ks * 4096 + half * 2048; }
template <int OFF> __device__ __forceinline__ s16x4 tr_read(int vb) { s16x4 r; asm volatile("ds_read_b64_tr_b16 %0, %1 offset:%2" : "=&v"(r) : "v"(vb), "i"(OFF) : "memory"); return r; }
template <int D0> __device__ __forceinline__ void pv_one(f32x16& od, int vb, bf16x8 pa0, bf16x8 pa1, bf16x8 pa2, bf16x8 pa3) {
    s16x4 l0 = tr_read<v_rd_off(D0, 0, 0)>(vb), h0 = tr_read<v_rd_off(D0, 0, 1)>(vb), l1 = tr_read<v_rd_off(D0, 1, 0)>(vb), h1 = tr_read<v_rd_off(D0, 1, 1)>(vb);
    s16x4 l2 = tr_read<v_rd_off(D0, 2, 0)>(vb), h2 = tr_read<v_rd_off(D0, 2, 1)>(vb), l3 = tr_read<v_rd_off(D0, 3, 0)>(vb), h3 = tr_read<v_rd_off(D0, 3, 1)>(vb);
#ifdef NO_SBAR
    asm volatile("s_waitcnt lgkmcnt(0)" : "+v"(l0), "+v"(h0), "+v"(l1), "+v"(h1), "+v"(l2), "+v"(h2), "+v"(l3), "+v"(h3) :: "memory");
#else
    asm volatile("s_waitcnt lgkmcnt(0)" ::: "memory"); SBAR();
#endif
#define PK(L, H) (bf16x8){L[0], L[1], L[2], L[3], H[0], H[1], H[2], H[3]}
    od = __builtin_amdgcn_mfma_f32_32x32x16_bf16(pa0, PK(l0, h0), od, 0, 0, 0);
    od = __builtin_amdgcn_mfma_f32_32x32x16_bf16(pa1, PK(l1, h1), od, 0, 0, 0);
    od = __builtin_amdgcn_mfma_f32_32x32x16_bf16(pa2, PK(l2, h2), od, 0, 0, 0);
    od = __builtin_amdgcn_mfma_f32_32x32x16_bf16(pa3, PK(l3, h3), od, 0, 0, 0);
#undef PK
}
__device__ __forceinline__ void pv_d0(f32x16 (&o)[4], int vb, bf16x8 pa0, bf16x8 pa1, bf16x8 pa2, bf16x8 pa3) {
    pv_one<0>(o[0], vb, pa0, pa1, pa2, pa3); pv_one<1>(o[1], vb, pa0, pa1, pa2, pa3); pv_one<2>(o[2], vb, pa0, pa1, pa2, pa3); pv_one<3>(o[3], vb, pa0, pa1, pa2, pa3);
}
template <bool BAND>
__device__ __forceinline__ void partialSM(f32x16& p0, f32x16& p1, float& m_reg, float& mn, float& alpha, float C, float cb, const LAS float* tbl, int relb, int hi) {
    if constexpr (BAND) {
#pragma unroll
        for (int r = 0; r < 16; ++r) { int i0 = relb + crow(r, hi), i1 = i0 + 32; i0 = min(max(i0, 0), 256); i1 = min(max(i1, 0), 256);
            p0[r] = fmaf(p0[r], C, tbl[i0]); p1[r] = fmaf(p1[r], C, tbl[i1]); }
    }
    float pmax = p0[0];
#pragma unroll
    for (int r = 1; r < 16; ++r) pmax = fmaxf(pmax, p0[r]);
#pragma unroll
    for (int r = 0; r < 16; ++r) pmax = fmaxf(pmax, p1[r]);
    { auto rr = __builtin_amdgcn_permlane32_swap(__float_as_uint(pmax), __float_as_uint(pmax), false, false);
      pmax = fmaxf(__uint_as_float(rr[0]), __uint_as_float(rr[1])); }
    const float ymax = BAND ? pmax : fmaf(pmax, C, cb);
    if (__builtin_expect(__all(ymax - m_reg <= THR2), 1)) { mn = m_reg; alpha = 1.f; }
    else { mn = fmaxf(m_reg, ymax); alpha = __builtin_amdgcn_exp2f(m_reg - mn); m_reg = mn; }
    if constexpr (BAND) {
#pragma unroll
        for (int r = 0; r < 16; ++r) { p0[r] -= mn; p1[r] -= mn; }
    } else {
        const float a = cb - mn;
#pragma unroll
        for (int r = 0; r < 16; ++r) { p0[r] = fmaf(p0[r], C, a); p1[r] = fmaf(p1[r], C, a); }
    }
#pragma unroll
    for (int r = 0; r < 16; ++r) p0[r] = __builtin_amdgcn_exp2f(p0[r]);
}
__device__ __forceinline__ void finishSM(f32x16& p0, f32x16& p1, float alpha, float& l_reg, bf16x8& pa0, bf16x8& pa1, bf16x8& pa2, bf16x8& pa3) {
#pragma unroll
    for (int r = 0; r < 16; ++r) p1[r] = __builtin_amdgcn_exp2f(p1[r]);
    float ps = 0;
#pragma unroll
    for (int r = 0; r < 16; ++r) ps += p0[r];
#pragma unroll
    for (int r = 0; r < 16; ++r) ps += p1[r];
    { auto rr = __builtin_amdgcn_permlane32_swap(__float_as_uint(ps), __float_as_uint(ps), false, false);
      ps = __uint_as_float(rr[0]) + __uint_as_float(rr[1]); }
    l_reg = l_reg * alpha + ps;
#define PK4(P, BASE, OUT) do { unsigned a0 = cvt_pk_bf16(P[BASE + 0], P[BASE + 1]), a1 = cvt_pk_bf16(P[BASE + 2], P[BASE + 3]);   \
    unsigned b0 = cvt_pk_bf16(P[BASE + 4], P[BASE + 5]), b1 = cvt_pk_bf16(P[BASE + 6], P[BASE + 7]);                              \
    auto r0 = __builtin_amdgcn_permlane32_swap(a0, b0, false, false); auto r1 = __builtin_amdgcn_permlane32_swap(a1, b1, false, false); \
    u32x4 w = {r0[0], r1[0], r0[1], r1[1]}; OUT = *reinterpret_cast<bf16x8*>(&w); } while (0)
    PK4(p0, 0, pa0); PK4(p0, 8, pa1); PK4(p1, 0, pa2); PK4(p1, 8, pa3);
#undef PK4
}
template <int DQK, int QREG>
__device__ __forceinline__ void qkt(f32x16& p0, f32x16& p1, const LAS unsigned char* Ks, const bf16x8 (&qr)[QREG], const LAS unsigned char* ql, int r32, int hi) {
    p0 = f32x16{}; p1 = f32x16{};
#pragma unroll
    for (int d0 = 0; d0 < DQK / 16; ++d0) { const int c = d0 * 2 + hi;
        const bf16x8 b0 = *(const LAS bf16x8*)(Ks + koff<DQK>(r32, c));
        const bf16x8 b1 = *(const LAS bf16x8*)(Ks + koff<DQK>(32 + r32, c));
        bf16x8 q; if (d0 < QREG) q = qr[d0 < QREG ? d0 : 0]; else q = *(const LAS bf16x8*)(ql + (d0 - QREG) * 1024);
        p0 = __builtin_amdgcn_mfma_f32_32x32x16_bf16(b0, q, p0, 0, 0, 0);
        p1 = __builtin_amdgcn_mfma_f32_32x32x16_bf16(b1, q, p1, 0, 0, 0); }
}

template <int OFF> __device__ __forceinline__ bf16x8 ldsr128(int addr) { bf16x8 r; asm volatile("ds_read_b128 %0, %1 offset:%2" : "=v"(r) : "v"(addr), "i"(OFF) : "memory"); return r; }
template <int BUF, int QREG>
__device__ __forceinline__ void qkt192(f32x16& p0, f32x16& p1, const int (&kb)[4], const bf16x8 (&qr)[QREG], const LAS unsigned char* ql) {
    p0 = f32x16{}; p1 = f32x16{};
#define QKT_G(G) do { \
        bf16x8 a0 = ldsr128<BUF * 24576 + 128 * G>(kb[0]), b0 = ldsr128<BUF * 24576 + 128 * G + 12288>(kb[0]); \
        bf16x8 a1 = ldsr128<BUF * 24576 + 128 * G>(kb[1]), b1 = ldsr128<BUF * 24576 + 128 * G + 12288>(kb[1]); \
        bf16x8 a2 = ldsr128<BUF * 24576 + 128 * G>(kb[2]), b2 = ldsr128<BUF * 24576 + 128 * G + 12288>(kb[2]); \
        bf16x8 a3 = ldsr128<BUF * 24576 + 128 * G>(kb[3]), b3 = ldsr128<BUF * 24576 + 128 * G + 12288>(kb[3]); \
        bf16x8 q0, q1, q2, q3; \
        if (4 * G + 0 < QREG) q0 = qr[4 * G + 0 < QREG ? 4 * G + 0 : 0]; else q0 = *(const LAS bf16x8*)(ql + (4 * G + 0 - QREG) * 1024); \
        if (4 * G + 1 < QREG) q1 = qr[4 * G + 1 < QREG ? 4 * G + 1 : 0]; else q1 = *(const LAS bf16x8*)(ql + (4 * G + 1 - QREG) * 1024); \
        if (4 * G + 2 < QREG) q2 = qr[4 * G + 2 < QREG ? 4 * G + 2 : 0]; else q2 = *(const LAS bf16x8*)(ql + (4 * G + 2 - QREG) * 1024); \
        if (4 * G + 3 < QREG) q3 = qr[4 * G + 3 < QREG ? 4 * G + 3 : 0]; else q3 = *(const LAS bf16x8*)(ql + (4 * G + 3 - QREG) * 1024); \
        asm volatile("s_waitcnt lgkmcnt(0)" : "+v"(a0), "+v"(b0), "+v"(a1), "+v"(b1), "+v"(a2), "+v"(b2), "+v"(a3), "+v"(b3) :: "memory"); \
        p0 = __builtin_amdgcn_mfma_f32_32x32x16_bf16(a0, q0, p0, 0, 0, 0); p1 = __builtin_amdgcn_mfma_f32_32x32x16_bf16(b0, q0, p1, 0, 0, 0); \
        p0 = __builtin_amdgcn_mfma_f32_32x32x16_bf16(a1, q1, p0, 0, 0, 0); p1 = __builtin_amdgcn_mfma_f32_32x32x16_bf16(b1, q1, p1, 0, 0, 0); \
        p0 = __builtin_amdgcn_mfma_f32_32x32x16_bf16(a2, q2, p0, 0, 0, 0); p1 = __builtin_amdgcn_mfma_f32_32x32x16_bf16(b2, q2, p1, 0, 0, 0); \
        p0 = __builtin_amdgcn_mfma_f32_32x32x16_bf16(a3, q3, p0, 0, 0, 0); p1 = __builtin_amdgcn_mfma_f32_32x32x16_bf16(b3, q3, p1, 0, 0, 0); } while (0)
    QKT_G(0); QKT_G(1); QKT_G(2);
#undef QKT_G
}
template <int DQK, bool BIAS, int ldq, int ldk, int ldv, int SDEPTH, int QREG>
__device__ __forceinline__ void attn_body(const bf16_t* __restrict__ Qb, const bf16_t* __restrict__ Kh, const bf16_t* __restrict__ Vh,
                                          LAS unsigned char* lds, float C, int q0, float cb_lo, float cb_hi, f32x16 (&o)[4]) {
    constexpr int NK = DQK / 64, CPR = DQK / 8, SHM_K = 64 * DQK * 2, NLD = 2 + NK;
    int tid_ = threadIdx.x; asm volatile("" : "+v"(tid_));
    const int tid = tid_, wid = tid >> 6, lane = tid & 63, r32 = lane & 31, hi = lane >> 5;
    LAS unsigned char* V_lds = lds; LAS unsigned char* K_lds = lds + OFF_K;
    LAS float* ws = (LAS float*)(lds + OFF_WS) + wid * 64; LAS float* li_l = ws; LAS float* al_l = ws + 32;
    const LAS float* tbl = (const LAS float*)(lds + OFF_TBL);
    float m_reg = -1e30f, l_reg = 0;
#pragma unroll
    for (int d = 0; d < 4; ++d) o[d] = f32x16{};
    bf16x8 qr[QREG];
    const bf16_t* Qw = Qb + (size_t)(wid * QBLK + r32) * ldq + hi * 8;
    LAS unsigned char* ql = lds + OFF_QL + wid * 8192 + lane * 16;
#pragma unroll
    for (int d0 = 0; d0 < DQK / 16; ++d0) { const bf16x8 q = *(const bf16x8*)(Qw + d0 * 16); if (d0 < QREG) qr[d0 < QREG ? d0 : 0] = q; else *(LAS bf16x8*)(ql + (d0 - QREG) * 1024) = q; }
    const int sr = tid >> 4, sc = (tid & 15) * 8, vst0 = v_st(sr, sc), vst1 = vst0 + 8192;
    unsigned kgo[NK]; int klo[NK];
#pragma unroll
    for (int i = 0; i < NK; ++i) { const int id = tid + 512 * i, row = id / CPR, c = id - row * CPR; kgo[i] = (unsigned)(row * ldk + c * 8) * 2u; klo[i] = koff<DQK>(row, c); }
    const unsigned vgo0 = (unsigned)(sr * ldv + sc) * 2u, vgo1 = vgo0 + (unsigned)(32 * ldv * 2);
    const int vb0 = (int)(uintptr_t)V_lds + v_rd_base(lane);
    int kb4[4];
#pragma unroll
    for (int e = 0; e < 4; ++e) kb4[e] = (int)(uintptr_t)K_lds + koff<DQK>(r32, 2 * e + hi);
#define QKT(P0, P1, BUF) do { if constexpr (DQK == 192) qkt192<BUF, QREG>(P0, P1, kb4, qr, ql); else qkt<DQK, QREG>(P0, P1, K_lds + BUF * SHM_K, qr, ql, r32, hi); } while (0)
    struct Slot { bf16x8 v0, v1, k[NK]; } slots[SDEPTH];
#define sl0 slots[0]
#define sl1 slots[SDEPTH - 1]
    const int qabs = q0 + wid * QBLK + r32;
#define SLOAD(sl, k0) do { const char* vb_ = (const char*)(Vh + (size_t)(k0) * ldv); const char* kb_ = (const char*)(Kh + (size_t)(k0) * ldk); \
    sl.v0 = *(const bf16x8*)(vb_ + vgo0); sl.v1 = *(const bf16x8*)(vb_ + vgo1); \
    _Pragma("unroll") for (int _i = 0; _i < NK; ++_i) sl.k[_i] = *(const bf16x8*)(kb_ + kgo[_i]); } while (0)
#define SWRITE(b, sl) do { *(LAS bf16x8*)(V_lds + (b) * SHM_V + vst0) = sl.v0; *(LAS bf16x8*)(V_lds + (b) * SHM_V + vst1) = sl.v1; \
    _Pragma("unroll") for (int _i = 0; _i < NK; ++_i) *(LAS bf16x8*)(K_lds + (b) * SHM_K + klo[_i]) = sl.k[_i]; } while (0)
#define SWAIT() do { if constexpr (SDEPTH == 1) asm volatile("s_waitcnt vmcnt(0)" ::: "memory"); else if constexpr (NLD == 3) asm volatile("s_waitcnt vmcnt(3)" ::: "memory"); else asm volatile("s_waitcnt vmcnt(5)" ::: "memory"); } while (0)
#define RESC(a) do { if (__any((a) < 1.f)) { if (hi == 0) al_l[r32] = (a); asm volatile("s_waitcnt lgkmcnt(0)" ::: "memory"); \
    _Pragma("unroll") for (int d = 0; d < 4; ++d) _Pragma("unroll") for (int r = 0; r < 16; ++r) o[d][r] *= al_l[crow(r, hi)]; } } while (0)
#define PSM(P0, P1, MN, AL, t) do { if constexpr (BIAS) { const int k0_ = (t) * KVBLK; \
        if (k0_ <= q0 - 191 || k0_ >= q0 + 383) partialSM<false>(P0, P1, m_reg, MN, AL, C, k0_ < q0 ? cb_lo : cb_hi, tbl, 0, hi); \
        else partialSM<true>(P0, P1, m_reg, MN, AL, C, 0.f, tbl, k0_ - qabs + 128, hi); } \
      else partialSM<false>(P0, P1, m_reg, MN, AL, C, 0.f, tbl, 0, hi); } while (0)
    f32x16 pA0, pA1, pB0, pB1; float mnA, mnB, alA, alB; bf16x8 pa0, pa1, pa2, pa3; const int NT = S / KVBLK;
    if (wid >= 4) __builtin_amdgcn_s_setprio(1);
    SLOAD(sl0, 0); asm volatile("s_waitcnt vmcnt(0)" ::: "memory"); SWRITE(0, sl0); __syncthreads();
    QKT(pA0, pA1, 0); PSM(pA0, pA1, mnA, alA, 0);
    SLOAD(sl1, KVBLK); if constexpr (SDEPTH == 2) SLOAD(sl0, 2 * KVBLK);
    SWAIT(); SWRITE(1, sl1); __syncthreads();
    for (int j = 1; j + 1 < NT; j += 2) {
        SBAR(); QKT(pB0, pB1, 1);
        finishSM(pA0, pA1, alA, l_reg, pa0, pa1, pa2, pa3); SBAR();
        SLOAD(sl1, (j + SDEPTH) * KVBLK); SBAR();
        pv_d0(o, vb0, pa0, pa1, pa2, pa3); PSM(pB0, pB1, mnB, alB, j);
        __syncthreads(); SWAIT(); SWRITE(0, sl0);
        RESC(alB); __syncthreads();
        SBAR(); QKT(pA0, pA1, 0);
        finishSM(pB0, pB1, alB, l_reg, pa0, pa1, pa2, pa3); SBAR();
        if (SDEPTH == 1 || j + 3 < NT) SLOAD(sl0, (j + 1 + SDEPTH) * KVBLK); SBAR();
        pv_d0(o, vb0 + SHM_V, pa0, pa1, pa2, pa3); PSM(pA0, pA1, mnA, alA, j + 1);
        __syncthreads(); SWAIT(); SWRITE(1, sl1);
        RESC(alA); __syncthreads();
    }
    SBAR(); QKT(pB0, pB1, 1);
    finishSM(pA0, pA1, alA, l_reg, pa0, pa1, pa2, pa3); SBAR();
    pv_d0(o, vb0, pa0, pa1, pa2, pa3); PSM(pB0, pB1, mnB, alB, NT - 1);
    __syncthreads(); RESC(alB);
    finishSM(pB0, pB1, alB, l_reg, pa0, pa1, pa2, pa3); SBAR();
    pv_d0(o, vb0 + SHM_V, pa0, pa1, pa2, pa3);
    __builtin_amdgcn_s_setprio(0);
    if (hi == 0) li_l[r32] = l_reg; asm volatile("s_waitcnt lgkmcnt(0)" ::: "memory");
#pragma unroll
    for (int r = 0; r < 16; ++r) { const float rl = __builtin_amdgcn_rcpf(li_l[crow(r, hi)]);
#pragma unroll
        for (int d = 0; d < 4; ++d) o[d][r] *= rl; }
#undef SLOAD
#undef sl0
#undef sl1
#undef SWRITE
#undef SWAIT
#undef RESC
#undef PSM
#undef QKT
}

template <int DQK, bool BIAS, int ldq, int ldk, int ldv, int QREG>
__device__ __forceinline__ void attn_body1(const bf16_t* __restrict__ Qb, const bf16_t* __restrict__ Kh, const bf16_t* __restrict__ Vh,
                                           LAS unsigned char* lds, float C, int q0, float cb_lo, float cb_hi, f32x16 (&o)[4]) {
    constexpr int NK = DQK / 64, CPR = DQK / 8, SHM_K = 64 * DQK * 2;
    int tid_ = threadIdx.x; asm volatile("" : "+v"(tid_));
    const int tid = tid_, wid = tid >> 6, lane = tid & 63, r32 = lane & 31, hi = lane >> 5;
    LAS unsigned char* V_lds = lds; LAS unsigned char* K_lds = lds + OFF_K;
    LAS float* ws = (LAS float*)(lds + OFF_WS) + wid * 64; LAS float* li_l = ws; LAS float* al_l = ws + 32;
    const LAS float* tbl = (const LAS float*)(lds + OFF_TBL);
    float m_reg = -1e30f, l_reg = 0;
#pragma unroll
    for (int d = 0; d < 4; ++d) o[d] = f32x16{};
    bf16x8 qr[QREG];
    const bf16_t* Qw = Qb + (size_t)(wid * QBLK + r32) * ldq + hi * 8;
    LAS unsigned char* ql = lds + OFF_QL + wid * 8192 + lane * 16;
#pragma unroll
    for (int d0 = 0; d0 < DQK / 16; ++d0) { const bf16x8 q = *(const bf16x8*)(Qw + d0 * 16); if (d0 < QREG) qr[d0 < QREG ? d0 : 0] = q; else *(LAS bf16x8*)(ql + (d0 - QREG) * 1024) = q; }
    const int sr = tid >> 4, sc = (tid & 15) * 8, vst0 = v_st(sr, sc), vst1 = vst0 + 8192;
    unsigned kgo[NK]; int klo[NK];
#pragma unroll
    for (int i = 0; i < NK; ++i) { const int id = tid + 512 * i, row = id / CPR, c = id - row * CPR; kgo[i] = (unsigned)(row * ldk + c * 8) * 2u; klo[i] = koff<DQK>(row, c); }
    const unsigned vgo0 = (unsigned)(sr * ldv + sc) * 2u, vgo1 = vgo0 + (unsigned)(32 * ldv * 2);
    const int vb0 = (int)(uintptr_t)V_lds + v_rd_base(lane);
    bf16x8 sv0, sv1, sk[NK];
    const int qabs = q0 + wid * QBLK + r32;
#define SLOAD1(k0) do { const char* vb_ = (const char*)(Vh + (size_t)(k0) * ldv); const char* kb_ = (const char*)(Kh + (size_t)(k0) * ldk); \
    sv0 = *(const bf16x8*)(vb_ + vgo0); sv1 = *(const bf16x8*)(vb_ + vgo1); \
    _Pragma("unroll") for (int _i = 0; _i < NK; ++_i) sk[_i] = *(const bf16x8*)(kb_ + kgo[_i]); } while (0)
#define SWRITE1(b) do { *(LAS bf16x8*)(V_lds + (b) * SHM_V + vst0) = sv0; *(LAS bf16x8*)(V_lds + (b) * SHM_V + vst1) = sv1; \
    _Pragma("unroll") for (int _i = 0; _i < NK; ++_i) *(LAS bf16x8*)(K_lds + (b) * SHM_K + klo[_i]) = sk[_i]; } while (0)
    constexpr int NT = S / KVBLK;
    if (wid >= 4) __builtin_amdgcn_s_setprio(1);
    SLOAD1(0); asm volatile("s_waitcnt vmcnt(0)" ::: "memory"); SWRITE1(0); __syncthreads();
    for (int j = 0; j < NT; ++j) {
        const int b = j & 1;
        if (j + 1 < NT) SLOAD1((j + 1) * KVBLK);
        f32x16 p0, p1; float mn, al; bf16x8 pa0, pa1, pa2, pa3;
        qkt<DQK, QREG>(p0, p1, K_lds + b * SHM_K, qr, ql, r32, hi);
        if constexpr (BIAS) { const int k0_ = j * KVBLK;
            if (k0_ <= q0 - 191) partialSM<false>(p0, p1, m_reg, mn, al, C, cb_lo, tbl, 0, hi);
            else if (k0_ >= q0 + 383) partialSM<false>(p0, p1, m_reg, mn, al, C, cb_hi, tbl, 0, hi);
            else partialSM<true>(p0, p1, m_reg, mn, al, C, 0.f, tbl, k0_ - qabs + 128, hi); }
        else partialSM<false>(p0, p1, m_reg, mn, al, C, 0.f, tbl, 0, hi);
        finishSM(p0, p1, al, l_reg, pa0, pa1, pa2, pa3);
        if (__any(al < 1.f)) { if (hi == 0) al_l[r32] = al; asm volatile("s_waitcnt lgkmcnt(0)" ::: "memory");
#pragma unroll
            for (int d = 0; d < 4; ++d)
#pragma unroll
                for (int r = 0; r < 16; ++r) o[d][r] *= al_l[crow(r, hi)]; }
        pv_d0(o, vb0 + b * SHM_V, pa0, pa1, pa2, pa3);
        if (j + 1 < NT) SWRITE1(b ^ 1);
        __syncthreads();
    }
    __builtin_amdgcn_s_setprio(0);
    if (hi == 0) li_l[r32] = l_reg; asm volatile("s_waitcnt lgkmcnt(0)" ::: "memory");
#pragma unroll
    for (int r = 0; r < 16; ++r) { const float rl = __builtin_amdgcn_rcpf(li_l[crow(r, hi)]);
#pragma unroll
        for (int d = 0; d < 4; ++d) o[d][r] *= rl; }
#undef SLOAD1
#undef SWRITE1
}


template <int BUF>
__device__ __forceinline__ void qkt192n(f32x16& p0, f32x16& p1, const int (&kb)[4], const bf16x8 (&qr)[12], const f32x16& nm) {
#define QKT_G(G) do { \
        bf16x8 a0 = ldsr128<BUF * 24576 + 128 * G>(kb[0]), b0 = ldsr128<BUF * 24576 + 128 * G + 12288>(kb[0]); \
        bf16x8 a1 = ldsr128<BUF * 24576 + 128 * G>(kb[1]), b1 = ldsr128<BUF * 24576 + 128 * G + 12288>(kb[1]); \
        bf16x8 a2 = ldsr128<BUF * 24576 + 128 * G>(kb[2]), b2 = ldsr128<BUF * 24576 + 128 * G + 12288>(kb[2]); \
        bf16x8 a3 = ldsr128<BUF * 24576 + 128 * G>(kb[3]), b3 = ldsr128<BUF * 24576 + 128 * G + 12288>(kb[3]); \
        asm volatile("s_waitcnt lgkmcnt(0)" : "+v"(a0), "+v"(b0), "+v"(a1), "+v"(b1), "+v"(a2), "+v"(b2), "+v"(a3), "+v"(b3) :: "memory"); \
        p0 = __builtin_amdgcn_mfma_f32_32x32x16_bf16(a0, qr[4 * G + 0], G == 0 ? nm : p0, 0, 0, 0); p1 = __builtin_amdgcn_mfma_f32_32x32x16_bf16(b0, qr[4 * G + 0], G == 0 ? nm : p1, 0, 0, 0); \
        p0 = __builtin_amdgcn_mfma_f32_32x32x16_bf16(a1, qr[4 * G + 1], p0, 0, 0, 0); p1 = __builtin_amdgcn_mfma_f32_32x32x16_bf16(b1, qr[4 * G + 1], p1, 0, 0, 0); \
        p0 = __builtin_amdgcn_mfma_f32_32x32x16_bf16(a2, qr[4 * G + 2], p0, 0, 0, 0); p1 = __builtin_amdgcn_mfma_f32_32x32x16_bf16(b2, qr[4 * G + 2], p1, 0, 0, 0); \
        p0 = __builtin_amdgcn_mfma_f32_32x32x16_bf16(a3, qr[4 * G + 3], p0, 0, 0, 0); p1 = __builtin_amdgcn_mfma_f32_32x32x16_bf16(b3, qr[4 * G + 3], p1, 0, 0, 0); } while (0)
    QKT_G(0); QKT_G(1); QKT_G(2);
#undef QKT_G
}
__device__ __forceinline__ float sq8(u32x4 w) {
    float s = 0.f;
#pragma unroll
    for (int e = 0; e < 4; ++e) { const float lo = __uint_as_float(w[e] << 16), hi = __uint_as_float(w[e] & 0xffff0000u); s = fmaf(lo, lo, s); s = fmaf(hi, hi, s); }
    return s;
}
template <int DQK, bool BIAS, int ldq, int ldk, int ldv>
__device__ __forceinline__ void attn_f(const bf16_t* __restrict__ Qb, const bf16_t* __restrict__ Kh, const bf16_t* __restrict__ Vh,
                                       LAS unsigned char* lds, int q0, float cb_lo, float cb_hi, float kmax, float bmax, f32x16 (&o)[4]) {
    constexpr int RING = (DQK == 192) ? 3 : 2;
    constexpr int NK = DQK / 64, CPR = DQK / 8, SHM_K = (RING == 3) ? 24576 : 64 * DQK * 2, QREG = DQK / 16, NT = S / KVBLK;
    constexpr bool KPERM = (DQK == 64);
    int tid_ = threadIdx.x; asm volatile("" : "+v"(tid_));
    const int tid = tid_, wid = __builtin_amdgcn_readfirstlane(tid >> 6), lane = tid & 63, r32 = lane & 31, hi = lane >> 5;
    LAS unsigned char* V_lds = lds; LAS unsigned char* K_lds = lds + (RING == 3 ? OFF_K3 : OFF_K);
    LAS float* ws = (LAS float*)(lds + (RING == 3 ? OFF_WS3 : OFF_WS)) + wid * 64; LAS float* li_l = ws;
    const LAS float* tbl = (const LAS float*)(lds + OFF_TBL);
    float l_reg = 0.f;
#pragma unroll
    for (int d = 0; d < 4; ++d) o[d] = f32x16{};
    bf16x8 qr[QREG];
    const bf16_t* Qw = Qb + (size_t)(wid * QBLK + r32) * ldq + hi * 8;
    float qs = 0.f;
#pragma unroll
    for (int d0 = 0; d0 < QREG; ++d0) { qr[d0] = *(const bf16x8*)(Qw + d0 * 16); qs += sq8(__builtin_bit_cast(u32x4, qr[d0])); }
    { auto rr = __builtin_amdgcn_permlane32_swap(__float_as_uint(qs), __float_as_uint(qs), false, false); qs = __uint_as_float(rr[0]) + __uint_as_float(rr[1]); }
    const float nm_ref = -(sqrtf(qs) * kmax + bmax);
    f32x16 nm;
#pragma unroll
    for (int r = 0; r < 16; ++r) nm[r] = nm_ref;
    unsigned kgo[NK], vgo[2];
#pragma unroll
    for (int i = 0; i < NK; ++i) { const int p = (i * 8 + wid) * 64 + lane, rho = p / CPR, cph = p - rho * CPR, sw = ((rho >> 1) & 1) | (((rho >> 3) & 3) << 1), c = cph ^ sw;
        const int k = KPERM ? ((rho & ~0xC) | ((rho & 4) << 1) | ((rho & 8) >> 1)) : rho; kgo[i] = (unsigned)(k * ldk + c * 8) * 2u; }
#pragma unroll
    for (int i = 0; i < 2; ++i) { const int p = (i * 8 + wid) * 64 + lane, sub = p >> 5, w = p & 31, kk = (sub >> 2) * 8 + (w >> 2), k = (kk & ~0xC) | ((kk & 4) << 1) | ((kk & 8) >> 1), col = (sub & 3) * 32 + (w & 3) * 8;
        vgo[i] = (unsigned)(k * ldv + col) * 2u; }
    const int vb0 = (int)(uintptr_t)V_lds + v_rd_base(lane);
    const int qabs = q0 + wid * QBLK + r32;
    int kb4[4];
#pragma unroll
    for (int e = 0; e < 4; ++e) kb4[e] = (int)(uintptr_t)K_lds + koff<DQK>(r32, 2 * e + hi);
    const __amdgpu_buffer_rsrc_t krs = __builtin_amdgcn_make_buffer_rsrc((void*)Kh, 0, 0x7fffffff, 0x00020000), vrs = __builtin_amdgcn_make_buffer_rsrc((void*)Vh, 0, 0x7fffffff, 0x00020000);
#define DMA2(t, KB_, VB_) do { const int ko_ = (t) * (KVBLK * ldk * 2), vo_ = (t) * (KVBLK * ldv * 2); \
    _Pragma("unroll") for (int _i = 0; _i < NK; ++_i) __builtin_amdgcn_raw_ptr_buffer_load_lds(krs, (LAS void*)(K_lds + (KB_) + (_i * 8 + wid) * 1024), 16, kgo[_i], ko_, 0, 0); \
    _Pragma("unroll") for (int _i = 0; _i < 2; ++_i) __builtin_amdgcn_raw_ptr_buffer_load_lds(vrs, (LAS void*)(V_lds + (VB_) + (_i * 8 + wid) * 1024), 16, vgo[_i], vo_, 0, 0); } while (0)
#define PK4(P, BASE, OUT) do { if constexpr (KPERM) { u32x4 w = {cvt_pk_bf16(P[BASE + 0], P[BASE + 1]), cvt_pk_bf16(P[BASE + 2], P[BASE + 3]), cvt_pk_bf16(P[BASE + 4], P[BASE + 5]), cvt_pk_bf16(P[BASE + 6], P[BASE + 7])}; \
        OUT = *reinterpret_cast<bf16x8*>(&w); } else { unsigned a0 = cvt_pk_bf16(P[BASE + 0], P[BASE + 1]), a1 = cvt_pk_bf16(P[BASE + 2], P[BASE + 3]), b0_ = cvt_pk_bf16(P[BASE + 4], P[BASE + 5]), b1_ = cvt_pk_bf16(P[BASE + 6], P[BASE + 7]); \
        auto r0 = __builtin_amdgcn_permlane32_swap(a0, b0_, false, false); auto r1 = __builtin_amdgcn_permlane32_swap(a1, b1_, false, false); \
        u32x4 w = {r0[0], r1[0], r0[1], r1[1]}; OUT = *reinterpret_cast<bf16x8*>(&w); } } while (0)
#define TILEC(KB_, VB_, t, QKB, BANDTILE) do { \
        f32x16 p0, p1; \
        if constexpr (DQK == 192) qkt192n<QKB>(p0, p1, kb4, qr, nm); else \
        { const LAS unsigned char* Ks = K_lds + (KB_); \
          _Pragma("unroll") for (int d0 = 0; d0 < DQK / 16; ++d0) { const int c = d0 * 2 + hi; \
              const bf16x8 b0 = *(const LAS bf16x8*)(Ks + koff<DQK>(r32, c)); const bf16x8 b1 = *(const LAS bf16x8*)(Ks + koff<DQK>(32 + r32, c)); \
              p0 = __builtin_amdgcn_mfma_f32_32x32x16_bf16(b0, qr[d0], d0 == 0 ? nm : p0, 0, 0, 0); p1 = __builtin_amdgcn_mfma_f32_32x32x16_bf16(b1, qr[d0], d0 == 0 ? nm : p1, 0, 0, 0); } } \
        if constexpr (BIAS && BANDTILE) { const int relb = (t) * KVBLK - qabs + 128; \
            _Pragma("unroll") for (int r = 0; r < 16; ++r) { int i0 = relb + (KPERM ? 16 * (r >> 3) + 8 * hi + (r & 7) : crow(r, hi)), i1 = i0 + 32; i0 = min(max(i0, 0), 256); i1 = min(max(i1, 0), 256); p0[r] += tbl[i0]; p1[r] += tbl[i1]; } } \
        _Pragma("unroll") for (int r = 0; r < 16; ++r) { p0[r] = __builtin_amdgcn_exp2f(p0[r]); p1[r] = __builtin_amdgcn_exp2f(p1[r]); } \
        float ps = 0; \
        _Pragma("unroll") for (int r = 0; r < 16; ++r) ps += p0[r]; \
        _Pragma("unroll") for (int r = 0; r < 16; ++r) ps += p1[r]; \
        if constexpr (!KPERM) { auto rr = __builtin_amdgcn_permlane32_swap(__float_as_uint(ps), __float_as_uint(ps), false, false); ps = __uint_as_float(rr[0]) + __uint_as_float(rr[1]); } \
        l_reg += ps; \
        bf16x8 pa0, pa1, pa2, pa3; PK4(p0, 0, pa0); PK4(p0, 8, pa1); PK4(p1, 0, pa2); PK4(p1, 8, pa3); \
        pv_d0(o, vb0 + (VB_), pa0, pa1, pa2, pa3); } while (0)
#define TILE3(B, t) do { if ((t) + 2 < NT) DMA2((t) + 2, (((B) + 2) % 3) * SHM_K, (((B) + 2) % 3) * SHM_V); \
        TILEC((B) * SHM_K, (B) * SHM_V, t, B, false); \
        if ((t) + 2 < NT) asm volatile("s_waitcnt vmcnt(5) lgkmcnt(0)\n\ts_barrier" ::: "memory"); else asm volatile("s_waitcnt vmcnt(0) lgkmcnt(0)\n\ts_barrier" ::: "memory"); } while (0)
#define TILEX(B, t, BANDTILE) do { if ((t) + 1 < NT) DMA2((t) + 1, ((B) ^ 1) * 8192, ((B) ^ 1) * 16384); \
        TILEC((B) * 8192, (B) * 16384, t, 0, BANDTILE); \
        asm volatile("s_waitcnt vmcnt(0)" ::: "memory"); __syncthreads(); } while (0)
#define SETNMC(cbv) do { const float nv_ = nm_ref + (cbv); _Pragma("unroll") for (int r = 0; r < 16; ++r) nm[r] = nv_; } while (0)
    static_assert(RING == 2 || NK + 2 == 5, "counted wait assumes 5 loads per thread per tile");
    if constexpr (RING == 3) {
        DMA2(0, 0, 0); DMA2(1, SHM_K, SHM_V); asm volatile("s_waitcnt vmcnt(0) lgkmcnt(0)\n\ts_barrier" ::: "memory");
        for (int j = 0; j + 2 < NT; j += 3) { TILE3(0, j); TILE3(1, j + 1); TILE3(2, j + 2); }
        static_assert((NT - 1) % 3 == 0, "tail tile must map to buffer 0");
        TILE3(0, NT - 1);
    } else {
        DMA2(0, 0, 0); asm volatile("s_waitcnt vmcnt(0)" ::: "memory"); __syncthreads();
        int t = 0;
        if constexpr (BIAS) {
            const int nL = q0 >= 191 ? (q0 - 191) / KVBLK + 1 : 0, tR = (q0 + 383 + KVBLK - 1) / KVBLK;
            const int a = (nL / 2) * 2; int be = ((tR + 1) / 2) * 2; if (be > NT) be = NT;
            SETNMC(cb_lo);
            for (; t < a; t += 2) { TILEX(0, t, false); TILEX(1, t + 1, false); }
            SETNMC(0.f);
            for (; t < be; t += 2) { TILEX(0, t, true); TILEX(1, t + 1, true); }
            SETNMC(cb_hi);
        }
        for (; t < NT; t += 2) { TILEX(0, t, false); TILEX(1, t + 1, false); }
    }
#undef TILEC
#undef TILE3
#undef TILEX
#undef SETNMC
#undef PK4
    if constexpr (KPERM) { auto rr = __builtin_amdgcn_permlane32_swap(__float_as_uint(l_reg), __float_as_uint(l_reg), false, false); l_reg = __uint_as_float(rr[0]) + __uint_as_float(rr[1]); }
    if (hi == 0) li_l[r32] = l_reg; asm volatile("s_waitcnt lgkmcnt(0)" ::: "memory");
#pragma unroll
    for (int r = 0; r < 16; ++r) { const float rl = __builtin_amdgcn_rcpf(li_l[crow(r, hi)]);
#pragma unroll
        for (int d = 0; d < 4; ++d) o[d][r] *= rl; }
#undef DMA2
}
}

__device__ __forceinline__ int t5_bucket(int rel) {
    const int n = rel < 0 ? -rel : rel; int b;
    if (n < 8) b = n; else if (n < 12) b = 8; else if (n < 16) b = 9; else if (n < 23) b = 10; else if (n < 32) b = 11; else if (n < 46) b = 12; else if (n < 64) b = 13; else if (n < 91) b = 14; else b = 15;
    return (rel > 0 ? 16 : 0) + b;
}
template <int KIND> __device__ __forceinline__ int dst_row(int n) {
    if constexpr (KIND == 1) { if (n < 3840) return n; const int d = n - 3840; return 3840 + (d < 32 ? 2 * d : 2 * (d - 32) + 1); }
    else if constexpr (KIND == 2) { const int h = n / 192, w = n - h * 192; if (w < 128) return n; const int d = w - 128; return h * 192 + 128 + (d < 32 ? 2 * d : 2 * (d - 32) + 1); }
    else if constexpr (KIND == 3) return 256 * (n >> 7) + (n & 127);
    else if constexpr (KIND == 4) return 256 * (n >> 7) + 128 + (n & 127);
    else return n;
}
template <int KIND>
__device__ __forceinline__ void transpose_item(const float* __restrict__ W, int K, int N, const float* __restrict__ g, bf16_t* __restrict__ WT, LAS float* scr, int item, int lane) {
    const int nblk = N / 32, kb = item / nblk, nb = item - kb * nblk, k0 = 64 * kb, n0 = 32 * nb;
#pragma unroll 8
    for (int i = 0; i < 32; ++i) { const int kk = 2 * i + (lane >> 5); float v = W[(size_t)(k0 + kk) * N + n0 + (lane & 31)]; if (g) v *= g[k0 + kk]; scr[kk * 33 + (lane & 31)] = v; }
    LDS_WAIT(); asm volatile("" ::: "memory");
    const int c = lane & 7;
#pragma unroll
    for (int j = 0; j < 4; ++j) { const int n = (lane >> 3) + 8 * j; const LAS float* s = scr + (8 * c) * 33 + n;
        u32x4 o; o.x = cvt_pk_bf16(s[0 * 33], s[1 * 33]); o.y = cvt_pk_bf16(s[2 * 33], s[3 * 33]); o.z = cvt_pk_bf16(s[4 * 33], s[5 * 33]); o.w = cvt_pk_bf16(s[6 * 33], s[7 * 33]);
        *(u32x4*)(WT + (size_t)dst_row<KIND>(n0 + n) * K + k0 + 8 * c) = o; }
    LDS_WAIT(); asm volatile("" ::: "memory");
}
__device__ __forceinline__ void rms_row_bf16(const float* __restrict__ xrow, const float* __restrict__ g, bf16_t* __restrict__ orow, int lane) {
    const f32x4* xr = (const f32x4*)xrow + lane; const f32x4* gr = (const f32x4*)g + lane;
    f32x4 v[8]; float s = 0.f;
#pragma unroll
    for (int j = 0; j < 8; ++j) { v[j] = xr[64 * j]; s += (v[j].x * v[j].x + v[j].y * v[j].y) + (v[j].z * v[j].z + v[j].w * v[j].w); }
    const float rstd = rsqrtf(wave_sum(s) * (1.f / DM) + EPS);
    u32x2* o8 = (u32x2*)orow + lane;
#pragma unroll
    for (int j = 0; j < 8; ++j) { const f32x4 gg = gr[64 * j]; u32x2 w; w.x = cvt_pk_bf16(v[j].x * rstd * gg.x, v[j].y * rstd * gg.y); w.y = cvt_pk_bf16(v[j].z * rstd * gg.z, v[j].w * rstd * gg.w); o8[64 * j] = w; }
}
__device__ __forceinline__ void rms_row_f32(float* xrow, const float* __restrict__ g, int lane) {
    f32x4* xr = (f32x4*)xrow + lane; const f32x4* gr = (const f32x4*)g + lane;
    f32x4 v[8]; float s = 0.f;
#pragma unroll
    for (int j = 0; j < 8; ++j) { v[j] = xr[64 * j]; s += (v[j].x * v[j].x + v[j].y * v[j].y) + (v[j].z * v[j].z + v[j].w * v[j].w); }
    const float rstd = rsqrtf(wave_sum(s) * (1.f / DM) + EPS);
#pragma unroll
    for (int j = 0; j < 8; ++j) xr[64 * j] = v[j] * rstd * gr[64 * j];
}

constexpr int LDS_BYTES = 147456;
struct Args { const float* in[19]; float* out; unsigned char* ws; int ph_lo, ph_hi; };

__global__ void __launch_bounds__(512, 2) fwd_mega(Args args) {
    extern __shared__ __attribute__((aligned(16))) unsigned char lds_raw[];
    LAS unsigned char* lds = (LAS unsigned char*)lds_raw;
    cg::grid_group grid = cg::this_grid();
    const int tid = threadIdx.x, lane = tid & 63, wave = __builtin_amdgcn_readfirstlane(tid >> 6);
    const int G = gridDim.x, bx = blockIdx.x;
    unsigned char* ws = args.ws;
    const float* x = args.in[0];
    bf16_t* Wt_uq = (bf16_t*)(ws + WS_WUQ); bf16_t* Wt_ukv = (bf16_t*)(ws + WS_WUKV); bf16_t* Wt_in = (bf16_t*)(ws + WS_WIN); bf16_t* Wt_out = (bf16_t*)(ws + WS_WOUT);
    bf16_t* Wt_gu = (bf16_t*)(ws + WS_WGU); bf16_t* Wt_dn = (bf16_t*)(ws + WS_WDN);
    bf16_t* HB = (bf16_t*)(ws + WS_HB); float* X1 = (float*)(ws + WS_X1); float* O1 = (float*)(ws + WS_O1);
    bf16_t* CQ = (bf16_t*)(ws + WS_CQ); bf16_t* CKV = (bf16_t*)(ws + WS_CKV); bf16_t* VB = (bf16_t*)(ws + WS_VB);
    bf16_t* QA = (bf16_t*)(ws + WS_QA); bf16_t* KA = (bf16_t*)(ws + WS_KA); bf16_t* VA = (bf16_t*)(ws + WS_VA); bf16_t* QB = (bf16_t*)(ws + WS_QB); bf16_t* KB = (bf16_t*)(ws + WS_KB);
    bf16_t* ACT = (bf16_t*)(ws + WS_ACT);
    float* LAM = (float*)(ws + WS_CTL); float* TBL = (float*)(ws + WS_TBL); float* SSQQ = (float*)(ws + WS_SSQQ); float* SSQKV = (float*)(ws + WS_SSQKV);
    float* COS = (float*)(ws + WS_COS); float* SIN = (float*)(ws + WS_SIN);
    const int lo = args.ph_lo, hi_ph = args.ph_hi;
#ifndef PH_MASK
#define PH_MASK 0x1ff
#endif
#define IN(k) (((PH_MASK >> (k)) & 1) && lo <= (k) && (k) < hi_ph)
#define SEAM(k) do { if (IN(k) && IN((k) + 1)) grid.sync(); } while (0)

    if (IN(0)) {
        LAS float* scr = (LAS float*)(lds + wave * 16384);
        const int gw = bx * 8 + wave, NGW = G * 8;
        constexpr int I_IN = (DM / 64) * (NIN / 32), I_UQ = (QLR / 64) * (NQB / 32), I_UKV = (KVLR / 64) * (NKV / 32), I_OUT = (DM / 64) * (DM / 32), I_G = (DM / 64) * (DFF / 32), I_DN = (DFF / 64) * (DM / 32);
        constexpr int NITEMS = I_IN + I_UQ + I_UKV + I_OUT + 2 * I_G + I_DN;
        for (int it = gw; it < NITEMS; it += NGW) {
            int r = it;
            if (r < I_IN) { transpose_item<1>(args.in[2], DM, NIN, nullptr, Wt_in, scr, r, lane); continue; } r -= I_IN;
            if (r < I_UQ) { transpose_item<2>(args.in[4], QLR, NQB, args.in[3], Wt_uq, scr, r, lane); continue; } r -= I_UQ;
            if (r < I_UKV) { transpose_item<0>(args.in[6], KVLR, NKV, args.in[5], Wt_ukv, scr, r, lane); continue; } r -= I_UKV;
            if (r < I_OUT) { transpose_item<0>(args.in[13], DM, DM, nullptr, Wt_out, scr, r, lane); continue; } r -= I_OUT;
            if (r < I_G) { transpose_item<3>(args.in[15], DM, DFF, nullptr, Wt_gu, scr, r, lane); continue; } r -= I_G;
            if (r < I_G) { transpose_item<4>(args.in[16], DM, DFF, nullptr, Wt_gu, scr, r, lane); continue; } r -= I_G;
            transpose_item<0>(args.in[17], DFF, DM, nullptr, Wt_dn, scr, r, lane);
        }
        for (int m = gw; m < S; m += NGW) rms_row_bf16(x + (size_t)m * DM, args.in[1], HB + (size_t)m * DM, lane);
        const int gt = bx * 512 + tid, NGT = G * 512;
        for (int i = gt; i < (NINP - NIN) * DM / 8; i += NGT) ((u32x4*)(Wt_in + (size_t)NIN * DM))[i] = (u32x4){0u, 0u, 0u, 0u};
        for (int i = gt; i < S; i += NGT) { SSQQ[i] = 0.f; SSQKV[i] = 0.f; }
        for (int i = gt; i < S * 32; i += NGT) { const int pos = i >> 5, f = i & 31; const float inv = powf(10000.f, -(float)f / 32.f); const float ang = (float)pos * inv; COS[i] = cosf(ang); SIN[i] = sinf(ang); }
        if (gt < 32) ((float*)(ws + WS_KMXA))[gt] = 0.f; else if (gt < 64) ((float*)(ws + WS_KMXB))[gt - 32] = 0.f; else if (gt < 66) ((float*)(ws + WS_KMXR))[gt - 64] = 0.f;
        else if (gt < 74) { const int h = gt - 66; float mx = -1e30f; for (int bk = 0; bk < 32; ++bk) mx = fmaxf(mx, args.in[12][bk * 8 + h]); ((float*)(ws + WS_TBLMAX))[h] = mx * LOG2E; }
        for (int i = gt; i < 8 * 257; i += NGT) { const int h = i / 257, idx = i - h * 257; TBL[i] = args.in[12][t5_bucket(idx - 128) * 8 + h] * LOG2E; }
        if (bx == 0 && wave == 0) { const float s1 = wave_sum(args.in[7][lane] * args.in[8][lane]), s2 = wave_sum(args.in[9][lane] * args.in[10][lane]);
            if (lane == 0) LAM[0] = expf(s1) - expf(s2) + 0.2f; }
        __syncthreads();
    }
    SEAM(0);
    if (IN(1)) {
        pg8::Gemm g{HB, Wt_in, S, NINP, DM}; pg8::StaticOrder So; So.init(S, NINP, G, bx);
        EpiIn E{ws};
        pg8::gemm_phase<EpiIn, pg8::StaticOrder, true, true>(lds, g, So, E);
    }
    SEAM(1);
    if (IN(2)) {
        { pg8::Gemm g{CQ, Wt_uq, S, NQB, QLR}; pg8::StaticOrder So; So.init(S, NQB, G, bx); EpiQB E{QB, SSQQ, COS, SIN};
          pg8::gemm_phase<EpiQB, pg8::StaticOrder, true, true>(lds, g, So, E); }
        { pg8::Gemm g{CKV, Wt_ukv, S, NKV, KVLR}; pg8::StaticOrder So; So.init(S, NKV, G, bx); EpiKV E{KB, VB, SSQKV, (unsigned*)(ws + WS_KMXB)};
          pg8::gemm_phase<EpiKV, pg8::StaticOrder, true, true>(lds, g, So, E); }
    }
    SEAM(2);
    if (IN(3)) {
        const int r32 = lane & 31, hi = lane >> 5;
        const float lam = __uint_as_float(__builtin_amdgcn_readfirstlane(__float_as_uint(LAM[0])));
        LAS float* tbl_l = (LAS float*)(lds + att::OFF_TBL);
        const float* KMXA = (const float*)(ws + WS_KMXA); const float* KMXB = (const float*)(ws + WS_KMXB); const float* KMXR = (const float*)(ws + WS_KMXR); const float* TBLMAX = (const float*)(ws + WS_TBLMAX);
        float* OXb = O1 + (size_t)bx * (2 * 256 * 128);
#ifndef REPA
#define REPA 1
#endif
#ifndef REPB
#define REPB 1
#endif
        for (int rep = 0; rep < REPA; ++rep)
        for (int it = 0; ; ++it) {
            const int u = bx + (it >> 1) * G, mp = it & 1; if (u >= 512) break;
            const int h = u & 7, q0 = (u >> 3) * 256;
            for (int i = tid; i < 257; i += 512) tbl_l[i] = TBL[h * 257 + i];
            const float cb_lo = __uint_as_float(__builtin_amdgcn_readfirstlane(__float_as_uint(TBL[h * 257]))), cb_hi = __uint_as_float(__builtin_amdgcn_readfirstlane(__float_as_uint(TBL[h * 257 + 256])));
            f32x16 o[4];
            const float kmx = sqrtf(__uint_as_float(__builtin_amdgcn_readfirstlane(__float_as_uint(KMXA[(h * 2 + mp) * 2] + KMXA[(h * 2 + mp) * 2 + 1])))), bmx = __uint_as_float(__builtin_amdgcn_readfirstlane(__float_as_uint(TBLMAX[h])));
            att::attn_f<64, true, 1024, 1024, 1024>(QA + (size_t)q0 * 1024 + h * 128 + mp * 64, KA + h * 128 + mp * 64, VA + h * 128, lds, q0, cb_lo, cb_hi, kmx, bmx, o);
            { float* OX = OXb + mp * (256 * 128) + (wave * 32) * 128 + r32;
#pragma unroll
                for (int r = 0; r < 16; ++r)
#pragma unroll
                    for (int d = 0; d < 4; ++d) OX[att::crow(r, hi) * 128 + d * 32] = o[d][r]; }
            if (mp == 1) {
                __threadfence(); __syncthreads();
                const f32x2 gs = *(const f32x2*)(args.in[11] + 2 * lane);
                for (int rr = wave; rr < 256; rr += 32) {
                    float v0[4], v1[4], ss[4];
#pragma unroll
                    for (int q = 0; q < 4; ++q) { const int row = rr + 8 * q;
                        const f32x2 a = *(const f32x2*)(OXb + row * 128 + 2 * lane), b = *(const f32x2*)(OXb + 256 * 128 + row * 128 + 2 * lane);
                        v0[q] = a.x - lam * b.x; v1[q] = a.y - lam * b.y; ss[q] = v0[q] * v0[q] + v1[q] * v1[q]; }
#pragma unroll
                    for (int o_ = 1; o_ < 64; o_ <<= 1)
#pragma unroll
                        for (int q = 0; q < 4; ++q) ss[q] += __shfl_xor(ss[q], o_);
#pragma unroll
                    for (int q = 0; q < 4; ++q) { const float rstd = rsqrtf(ss[q] * (1.f / 128.f) + EPS) * 0.8f;
                        *(unsigned*)(HB + (size_t)(q0 + rr + 8 * q) * DM + h * 128 + 2 * lane) = cvt_pk_bf16(v0[q] * rstd * gs.x, v1[q] * rstd * gs.y); }
                }
                __syncthreads();
            }
        }
        for (int rep = 0; rep < REPB; ++rep)
        for (int u = bx; u < 512; u += G) {
            const int h = u & 7, q0 = (u >> 3) * 256;
            f32x16 o[4];
            const float kmx = sqrtf(__uint_as_float(__builtin_amdgcn_readfirstlane(__float_as_uint((KMXB[h * 4] + KMXB[h * 4 + 1]) + (KMXB[h * 4 + 2] + KMXB[h * 4 + 3]) + (KMXR[0] + KMXR[1])))));
            att::attn_f<192, false, NQB, NQB, 1024>(QB + (size_t)q0 * NQB + h * 192, KB + h * 192, VB + h * 128, lds, q0, 0.f, 0.f, kmx, 0.f, o);
            bf16_t* mix = HB + (size_t)(q0 + wave * 32) * DM + 1024 + h * 128 + r32;
#pragma unroll
            for (int r = 0; r < 16; ++r)
#pragma unroll
                for (int d = 0; d < 4; ++d) mix[(size_t)att::crow(r, hi) * DM + d * 32] = (bf16_t)(cvt_pk_bf16(o[d][r], 0.f) & 0xffffu);
        }
        __syncthreads();
    }
    SEAM(3);
    if (IN(4)) {
        pg8::Gemm g{HB, Wt_out, S, DM, DM}; pg8::StaticOrder So; So.init(S, DM, G, bx); EpiRes E{x, X1};
        pg8::gemm_phase<EpiRes, pg8::StaticOrder, true, true>(lds, g, So, E);
    }
    SEAM(4);
    if (IN(5)) {
        const int gw = bx * 8 + wave, NGW = G * 8;
        for (int m = gw; m < S; m += NGW) rms_row_bf16(X1 + (size_t)m * DM, args.in[14], HB + (size_t)m * DM, lane);
    }
    SEAM(5);
    if (IN(6)) {
        pg8::Gemm g{HB, Wt_gu, S, NGU, DM}; pg8::StaticOrder So; So.init(S, NGU, G, bx); EpiGU E{ACT};
#ifndef REP6
#define REP6 1
#endif
        for (int rep = 0; rep < REP6; ++rep)
        pg8::gemm_phase<EpiGU, pg8::StaticOrder, true, true>(lds, g, So, E);
    }
    SEAM(6);
    if (IN(7)) {
        pg8::Gemm g{ACT, Wt_dn, S, DM, DFF}; pg8::StaticOrder So; So.init(S, DM, G, bx); EpiRes E{X1, args.out};
        pg8::gemm_phase<EpiRes, pg8::StaticOrder, true, true>(lds, g, So, E);
    }
    SEAM(7);
    if (IN(8)) {
        const int gw = bx * 8 + wave, NGW = G * 8;
        for (int m = gw; m < S; m += NGW) rms_row_f32(args.out + (size_t)m * DM, args.in[18], lane);
    }
#undef IN
#undef SEAM
}

extern "C" void kernel_launch(void* const* d_in, const int* in_sizes, int n_in, void* d_out, int out_size, void* d_ws, size_t ws_size, hipStream_t stream) {
    static int grid = 0;
    if (grid == 0) {
        if (n_in != 19 || in_sizes[0] != S * DM || out_size != S * DM || ws_size < WS_END) {
            fprintf(stderr, "kernel_launch: shape/workspace mismatch: n_in %d in0 %d out %d ws %zu (need %zu)\n", n_in, n_in > 0 ? in_sizes[0] : -1, out_size, ws_size, (size_t)WS_END); grid = -1; return; }
        int dev = 0, cus = 0, per_cu = 0;
        (void)hipGetDevice(&dev); (void)hipDeviceGetAttribute(&cus, hipDeviceAttributeMultiprocessorCount, dev);
        if (hipFuncSetAttribute((const void*)fwd_mega, hipFuncAttributeMaxDynamicSharedMemorySize, LDS_BYTES) != hipSuccess) { fprintf(stderr, "kernel_launch: hipFuncSetAttribute failed\n"); grid = -1; return; }
        if (hipOccupancyMaxActiveBlocksPerMultiprocessor(&per_cu, (const void*)fwd_mega, 512, LDS_BYTES) != hipSuccess || per_cu < 1) { fprintf(stderr, "kernel_launch: occupancy query says %d\n", per_cu); per_cu = 1; }
        (void)hipGetLastError();
        grid = cus < 256 ? cus : 256;
    }
    if (grid < 0) return;
    Args a{};
    for (int i = 0; i < 19; ++i) a.in[i] = (const float*)d_in[i];
    a.out = (float*)d_out; a.ws = (unsigned char*)d_ws;
#if MK_N_LAUNCHES == 1
    a.ph_lo = 0; a.ph_hi = NPHASE;
    void* kargs[] = {&a};
    hipError_t e = hipLaunchCooperativeKernel((const void*)fwd_mega, dim3(grid), dim3(512), kargs, LDS_BYTES, stream);
    if (e != hipSuccess) fprintf(stderr, "kernel_launch: cooperative launch failed: %s (grid %d)\n", hipGetErrorString(e), grid);
#else
    for (int p = 0; p < NPHASE; ++p) { a.ph_lo = p; a.ph_hi = p + 1; hipLaunchKernelGGL(fwd_mega, dim3(grid), dim3(512), LDS_BYTES, stream, a); }
#endif
}
```

```cpp
#define NO_SBAR 1
#include <hip/hip_runtime.h>
#include <hip/hip_cooperative_groups.h>
#include <cstdio>
#include <cstdint>
namespace cg = cooperative_groups;

#ifndef MK_N_LAUNCHES
#define MK_N_LAUNCHES 1
#endif

#define LAS __attribute__((address_space(3)))
typedef unsigned short bf16_t;
typedef short bf16x8 __attribute__((ext_vector_type(8)));
typedef short s16x4 __attribute__((ext_vector_type(4)));
typedef float f32x4 __attribute__((ext_vector_type(4)));
typedef float f32x2 __attribute__((ext_vector_type(2)));
typedef float f32x16 __attribute__((ext_vector_type(16)));
typedef unsigned u32x4 __attribute__((ext_vector_type(4)));
typedef unsigned u32x2 __attribute__((ext_vector_type(2)));

constexpr int S = 16384, DM = 2048, NIN = 3904, NINP = 4096, DFF = 5632, NGU = 2 * DFF;
constexpr int QLR = 512, KVLR = 256, NQB = 1536, NKV = 2048;
constexpr float EPS = 1e-6f, LOG2E = 1.4426950408889634f;
constexpr int NPHASE = 9;

constexpr size_t MiB = 1u << 20;
constexpr size_t WS_CTL = 0;
constexpr size_t WS_TBL = 4096, WS_SSQQ = 65536, WS_SSQKV = 131072, WS_KMXA = 256, WS_KMXB = 384, WS_TBLMAX = 512, WS_KMXR = 640;
constexpr size_t WS_BAR = 262144;
constexpr size_t WS_COS = 1 * MiB, WS_SIN = 3 * MiB;
constexpr size_t WS_WUQ = 5 * MiB, WS_WUKV = 7 * MiB, WS_WIN = 8 * MiB, WS_WOUT = 24 * MiB, WS_WGU = 32 * MiB, WS_WDN = 76 * MiB;
constexpr size_t WS_HB = 98 * MiB;
constexpr size_t WS_X1 = 162 * MiB;
constexpr size_t WS_O1 = WS_X1, WS_CQ = WS_X1 + 64 * MiB, WS_CKV = WS_X1 + 80 * MiB, WS_VB = WS_X1 + 88 * MiB;
constexpr size_t WS_R = 290 * MiB;
constexpr size_t WS_QA = WS_R, WS_KA = WS_R + 32 * MiB, WS_VA = WS_R + 64 * MiB, WS_QB = WS_R + 96 * MiB, WS_KB = WS_R + 144 * MiB;
constexpr size_t WS_ACT = WS_R;
constexpr size_t WS_END = WS_R + 192 * MiB;

__device__ __forceinline__ unsigned cvt_pk_bf16(float lo, float hi) { unsigned r; asm volatile("v_cvt_pk_bf16_f32 %0, %1, %2" : "=v"(r) : "v"(lo), "v"(hi)); return r; }
__device__ __forceinline__ float wave_sum(float v) {
#pragma unroll
    for (int o = 1; o < 64; o <<= 1) v += __shfl_xor(v, o);
    return v;
}
#define LDS_WAIT() asm volatile("s_waitcnt lgkmcnt(0)" ::: "memory")

namespace pg8 {
constexpr int BM = 256, BK = 64, HALF = 128, HTB = HALF * BK * 2, STAGE_BYTES = 8 * HTB, NXCD = 8, WGM = 8;
__host__ __device__ __forceinline__ int lds_byte(int r, int c) { const int st = (r >> 4) * 2 + (c >> 5), rr = r & 15, cc = c & 31, ob = rr * 64 + cc * 2; return st * 1024 + (ob ^ (((ob >> 9) & 1) << 5)); }
__host__ __device__ __forceinline__ void stage_rc(int b, int& R, int& C) { const int st = b / 1024, sb = b % 1024, swz = sb ^ (((sb >> 9) & 1) << 5); R = (st >> 1) * 16 + swz / 64; C = (st & 1) * 32 + (swz % 64) / 2; }
__host__ __device__ __forceinline__ int perm32(int rho) { const int n = rho >> 4, i = rho & 15; return 8 * (i >> 2) + 4 * n + (i & 3); }
struct Unit { int pm, pn; };
struct Gemm { const bf16_t* A; const bf16_t* Bt; int M, N, K; };
struct StaticOrder {
    int nM, nN, nwg, G, c;
    __host__ __device__ void init(int M, int N, int G_, int c_) { nM = M / BM; nN = N / BM; nwg = nM * nN; G = G_; c = c_; }
    __host__ __device__ bool next(int i, Unit& u) const {
        const long L = (long)i * G + c; if (L >= nwg) return false;
        int wgid = (int)L; { const int q = nwg / NXCD, r = nwg % NXCD, xcd = wgid % NXCD, off = wgid / NXCD; wgid = (xcd < r ? xcd * (q + 1) : r * (q + 1) + (xcd - r) * q) + off; }
        const int nig = WGM * nN, gid = wgid / nig, fm = gid * WGM, gsz = (nM - fm) < WGM ? (nM - fm) : WGM;
        u.pm = fm + ((wgid % nig) % gsz); u.pn = (wgid % nig) / gsz; return true;
    }
    __device__ __forceinline__ void a_ready(const Unit&) const {}
    __device__ __forceinline__ void done(const Unit&) const {}
};
template <class Epi, class Sched, bool ALIGN_EPI = false, bool SP2 = false>
__device__ __forceinline__ void gemm_phase(LAS unsigned char* lds, const Gemm g, const Sched& Sd, const Epi& E) {
    int tid_ = threadIdx.x; asm volatile("" : "+v"(tid_));
    const int tid = tid_, wid = __builtin_amdgcn_readfirstlane(tid >> 6), lane = tid & 63, wr = wid >> 2, wc = wid & 3, fr = lane & 15, fq = lane >> 4;
    const int K = g.K, nt = K / BK;
    unsigned voffA[2], voffB[2];
#pragma unroll
    for (int i = 0; i < 2; ++i) { int R, C; stage_rc(tid * 16 + i * 8192, R, C); const int Rb = Epi::PERM ? ((R & ~31) + perm32(R & 31)) : R;
        voffA[i] = (unsigned)(R * K + C) * 2u; voffB[i] = (unsigned)(Rb * K + C) * 2u; }
    const size_t kstep = (size_t)(BK * 2);
    const size_t hstep = (size_t)HALF * K * 2;
    const size_t tstep = 2 * hstep;
    const unsigned ldsw = (unsigned)wid * 1024u;
    const int aoff = lds_byte(wr * 64 + fr, fq * 8), boff = lds_byte(wc * 32 + fr, fq * 8);
#define PG8_SA(b, h) (((b) * 2 + (h)) * HTB)
#define PG8_SB(b, h) ((4 + (b) * 2 + (h)) * HTB)
#define PG8_STAGE(bufoff, gbase, voff) do { _Pragma("unroll") for (int _i = 0; _i < 2; ++_i) \
        __builtin_amdgcn_global_load_lds((const unsigned*)((const char*)(gbase) + (voff)[_i]), (LAS unsigned*)(lds + (bufoff) + ldsw + _i * 8192), 16, 0, 0); } while (0)
#define PG8_LDA(dst, b, h) do { _Pragma("unroll") for (int m = 0; m < 4; ++m) _Pragma("unroll") for (int k = 0; k < 2; ++k) dst[m][k] = *(const LAS bf16x8*)(lds + PG8_SA(b, h) + aoff + m * 2048 + k * 1024); } while (0)
#define PG8_LDB(dst, b, h) do { _Pragma("unroll") for (int n = 0; n < 2; ++n) _Pragma("unroll") for (int k = 0; k < 2; ++k) dst[n][k] = *(const LAS bf16x8*)(lds + PG8_SB(b, h) + boff + n * 2048 + k * 1024); } while (0)
#define PG8_MMA(ai, bj, At, Bt) do { __builtin_amdgcn_s_setprio(1); _Pragma("unroll") for (int m = 0; m < 4; ++m) _Pragma("unroll") for (int n = 0; n < 2; ++n) _Pragma("unroll") for (int k = 0; k < 2; ++k) \
        acc[ai][bj][m][n] = __builtin_amdgcn_mfma_f32_16x16x32_bf16(Bt[n][k], At[m][k], acc[ai][bj][m][n], 0, 0, 0); __builtin_amdgcn_s_setprio(0); } while (0)
#define PG8_WAIT_V(n) asm volatile("s_waitcnt vmcnt(" #n ")" ::: "memory")
#define PG8_WAIT_L(n) asm volatile("s_waitcnt lgkmcnt(" #n ")" ::: "memory")
#define PG8_BAR __builtin_amdgcn_s_barrier()
#define PG8_SCHED __builtin_amdgcn_sched_barrier(0)
    Unit cur, nxt; int ui = 0;
    if (!Sd.next(0, cur)) return;
    f32x4 acc[2][2][4][2];
#pragma unroll
    for (int a = 0; a < 2; ++a)
#pragma unroll
        for (int b = 0; b < 2; ++b)
#pragma unroll
            for (int m = 0; m < 4; ++m)
#pragma unroll
                for (int n = 0; n < 2; ++n) acc[a][b][m][n] = (f32x4){0.f, 0.f, 0.f, 0.f};
    bf16x8 At[4][2], B0[2][2], B1[2][2];
    const char* cA = (const char*)g.A + (size_t)cur.pm * tstep; const char* cB = (const char*)g.Bt + (size_t)cur.pn * tstep;
    Sd.a_ready(cur);
    if constexpr (SP2) {
        PG8_STAGE(PG8_SB(0, 0), cB, voffB); PG8_STAGE(PG8_SB(0, 1), cB + hstep, voffB); PG8_STAGE(PG8_SA(0, 0), cA, voffA); PG8_STAGE(PG8_SA(0, 1), cA + hstep, voffA);
        if (wr == 1) PG8_BAR;
        PG8_WAIT_V(2); PG8_BAR;
        PG8_STAGE(PG8_SB(1, 0), cB + kstep, voffB); PG8_STAGE(PG8_SA(1, 0), cA + kstep, voffA); PG8_STAGE(PG8_SB(1, 1), cB + hstep + kstep, voffB);
        PG8_WAIT_V(6); PG8_BAR;
    } else {
        PG8_STAGE(PG8_SB(0, 0), cB, voffB); PG8_STAGE(PG8_SA(0, 0), cA, voffA); PG8_STAGE(PG8_SB(0, 1), cB + hstep, voffB); PG8_STAGE(PG8_SA(0, 1), cA + hstep, voffA);
        if (wr == 1) PG8_BAR;
        PG8_WAIT_V(4); PG8_BAR;
        PG8_STAGE(PG8_SB(1, 0), cB + kstep, voffB); PG8_STAGE(PG8_SA(1, 0), cA + kstep, voffA); PG8_STAGE(PG8_SB(1, 1), cB + hstep + kstep, voffB);
        PG8_WAIT_V(6); PG8_BAR;
    }
    for (;;) {
        const bool has_next = Sd.next(ui + 1, nxt);
        const char* nA = has_next ? (const char*)g.A + (size_t)nxt.pm * tstep : cA; const char* nB = has_next ? (const char*)g.Bt + (size_t)nxt.pn * tstep : cB;
        for (int t = 0; t < nt; t += 2) {
            const bool last = (t == nt - 2);
            const char* a1 = cA + (size_t)(t + 1) * kstep;
            const char* a2 = last ? nA : cA + (size_t)(t + 2) * kstep; const char* b2 = last ? nB : cB + (size_t)(t + 2) * kstep;
            const char* a3 = a2 + kstep; const char* b3 = b2 + kstep;
            if (last && has_next) Sd.a_ready(nxt);
            if constexpr (SP2) {
            PG8_LDB(B0, 0, 0); PG8_LDB(B1, 0, 1); PG8_SCHED; PG8_LDA(At, 0, 0); PG8_STAGE(PG8_SA(1, 1), a1 + hstep, voffA);
            PG8_WAIT_V(8); PG8_WAIT_L(0); PG8_BAR; PG8_MMA(0, 0, At, B0); PG8_MMA(0, 1, At, B1); PG8_BAR; PG8_SCHED;
            PG8_LDA(At, 0, 1); PG8_STAGE(PG8_SB(0, 0), b2, voffB); PG8_STAGE(PG8_SB(0, 1), b2 + hstep, voffB); PG8_STAGE(PG8_SA(0, 0), a2, voffA);
            PG8_WAIT_V(8); PG8_WAIT_L(0); PG8_BAR; PG8_MMA(1, 0, At, B0); PG8_MMA(1, 1, At, B1); PG8_BAR; PG8_SCHED;
            PG8_LDB(B0, 1, 0); PG8_LDB(B1, 1, 1); PG8_SCHED; PG8_LDA(At, 1, 0); PG8_STAGE(PG8_SA(0, 1), a2 + hstep, voffA);
            PG8_WAIT_V(8); PG8_WAIT_L(0); PG8_BAR; PG8_MMA(0, 0, At, B0); PG8_MMA(0, 1, At, B1); PG8_BAR; PG8_SCHED;
            PG8_LDA(At, 1, 1); PG8_STAGE(PG8_SB(1, 0), b3, voffB); PG8_STAGE(PG8_SB(1, 1), b3 + hstep, voffB); PG8_STAGE(PG8_SA(1, 0), a3, voffA);
            PG8_WAIT_V(8); PG8_WAIT_L(0); PG8_BAR; PG8_MMA(1, 0, At, B0); PG8_MMA(1, 1, At, B1); PG8_BAR; PG8_SCHED;
            } else {
            PG8_LDB(B0, 0, 0); PG8_SCHED; PG8_LDA(At, 0, 0); PG8_STAGE(PG8_SA(1, 1), a1 + hstep, voffA);
            PG8_WAIT_L(8); PG8_BAR; PG8_WAIT_L(0); PG8_MMA(0, 0, At, B0); PG8_BAR; PG8_SCHED;
            PG8_LDB(B1, 0, 1); PG8_STAGE(PG8_SB(0, 0), b2, voffB);
            PG8_BAR; PG8_WAIT_L(0); PG8_MMA(0, 1, At, B1); PG8_BAR;
            PG8_LDA(At, 0, 1); PG8_STAGE(PG8_SA(0, 0), a2, voffA);
            PG8_BAR; PG8_WAIT_L(0); PG8_MMA(1, 0, At, B0); PG8_BAR; PG8_SCHED;
            PG8_STAGE(PG8_SB(0, 1), b2 + hstep, voffB);
            PG8_WAIT_V(6); PG8_BAR; PG8_MMA(1, 1, At, B1); PG8_BAR;
            PG8_LDB(B0, 1, 0); PG8_SCHED; PG8_LDA(At, 1, 0); PG8_STAGE(PG8_SA(0, 1), a2 + hstep, voffA);
            PG8_WAIT_L(8); PG8_BAR; PG8_WAIT_L(0); PG8_MMA(0, 0, At, B0); PG8_BAR; PG8_SCHED;
            PG8_LDB(B1, 1, 1); PG8_STAGE(PG8_SB(1, 0), b3, voffB);
            PG8_BAR; PG8_WAIT_L(0); PG8_MMA(0, 1, At, B1); PG8_BAR;
            PG8_LDA(At, 1, 1); PG8_STAGE(PG8_SA(1, 0), a3, voffA);
            PG8_BAR; PG8_WAIT_L(0); PG8_MMA(1, 0, At, B0); PG8_BAR; PG8_SCHED;
            PG8_STAGE(PG8_SB(1, 1), b3 + hstep, voffB);
            PG8_WAIT_V(6); PG8_BAR; PG8_MMA(1, 1, At, B1); PG8_BAR;
            }
        }
        if constexpr (ALIGN_EPI) { if (wr == 0) PG8_BAR; }
        E(acc, cur, wr, wc, fr, fq); Sd.done(cur);
        if (!has_next) break;
#pragma unroll
        for (int a = 0; a < 2; ++a)
#pragma unroll
            for (int b = 0; b < 2; ++b)
#pragma unroll
                for (int m = 0; m < 4; ++m)
#pragma unroll
                    for (int n = 0; n < 2; ++n) acc[a][b][m][n] = (f32x4){0.f, 0.f, 0.f, 0.f};
        cur = nxt; cA = nA; cB = nB; ++ui;
        if constexpr (ALIGN_EPI) { if (wr == 1) PG8_BAR; }
    }
    PG8_WAIT_V(0);
    if constexpr (!ALIGN_EPI) { if (wr == 0) PG8_BAR; }
    PG8_BAR;
#undef PG8_SA
#undef PG8_SB
#undef PG8_STAGE
#undef PG8_LDA
#undef PG8_LDB
#undef PG8_MMA
#undef PG8_WAIT_V
#undef PG8_WAIT_L
#undef PG8_BAR
#undef PG8_SCHED
}
}

using pg8::Unit;
__device__ __forceinline__ u32x4 pack8(f32x4 a, f32x4 b) { u32x4 w; w.x = cvt_pk_bf16(a[0], a[1]); w.y = cvt_pk_bf16(a[2], a[3]); w.z = cvt_pk_bf16(b[0], b[1]); w.w = cvt_pk_bf16(b[2], b[3]); return w; }
__device__ __forceinline__ void rope8(f32x4& v0, f32x4& v1, f32x4 cs, f32x4 sn) {
    f32x4 a = v0, b = v1;
    v0[0] = a[0] * cs[0] - a[1] * sn[0]; v0[1] = a[1] * cs[0] + a[0] * sn[0];
    v0[2] = a[2] * cs[1] - a[3] * sn[1]; v0[3] = a[3] * cs[1] + a[2] * sn[1];
    v1[0] = b[0] * cs[2] - b[1] * sn[2]; v1[1] = b[1] * cs[2] + b[0] * sn[2];
    v1[2] = b[2] * cs[3] - b[3] * sn[3]; v1[3] = b[3] * cs[3] + b[2] * sn[3];
}
__device__ __forceinline__ float fr_max(float v) { v = fmaxf(v, __shfl_xor(v, 1)); v = fmaxf(v, __shfl_xor(v, 2)); v = fmaxf(v, __shfl_xor(v, 4)); v = fmaxf(v, __shfl_xor(v, 8)); return v; }
__device__ __forceinline__ float sq8f(f32x4 a, f32x4 b) { return (a[0] * a[0] + a[1] * a[1]) + (a[2] * a[2] + a[3] * a[3]) + (b[0] * b[0] + b[1] * b[1]) + (b[2] * b[2] + b[3] * b[3]); }
struct EpiIn {
    static constexpr bool PERM = true;
    unsigned char* ws;
    __device__ __forceinline__ void operator()(const f32x4 (&acc)[2][2][4][2], const Unit& u, int wr, int wc, int fr, int fq) const {
        const int row0 = u.pm * 256 + wr * 64 + fr, pn = u.pn, cl = wc * 32 + 8 * fq;
        bf16_t* KB = (bf16_t*)(ws + WS_KB); const float* COS = (const float*)(ws + WS_COS); const float* SIN = (const float*)(ws + WS_SIN);
        if (pn < 12) {
            bf16_t* base = (bf16_t*)(ws + WS_QA + (size_t)(pn >> 2) * (32 * MiB)); const int colt = (pn & 3) * 256 + cl; const float qsc = pn < 4 ? 0.125f * LOG2E : 1.f;
#pragma unroll
            for (int ai = 0; ai < 2; ++ai)
#pragma unroll
                for (int m = 0; m < 4; ++m) { bf16_t* rowp = base + (size_t)(row0 + ai * 128 + m * 16) * 1024 + colt;
#pragma unroll
                    for (int bj = 0; bj < 2; ++bj) *(u32x4*)(rowp + bj * 128) = pack8(acc[ai][bj][m][0] * qsc, acc[ai][bj][m][1] * qsc); }
            if (pn >= 4 && pn < 8) {
                float mx[2] = {0.f, 0.f};
#pragma unroll
                for (int ai = 0; ai < 2; ++ai)
#pragma unroll
                    for (int m = 0; m < 4; ++m)
#pragma unroll
                        for (int bj = 0; bj < 2; ++bj) { float q = sq8f(acc[ai][bj][m][0], acc[ai][bj][m][1]); q += __shfl_xor(q, 16); q += __shfl_xor(q, 32); mx[bj] = fmaxf(mx[bj], q); }
#pragma unroll
                for (int bj = 0; bj < 2; ++bj) { const float v = fr_max(mx[bj]); if (fr == 0 && fq == 0) atomicMax((unsigned*)(ws + WS_KMXA) + ((2 * (pn - 4) + bj) * 2 + (wc >> 1)) * 2 + (wc & 1), __float_as_uint(v)); }
            }
        } else if (pn < 15) {
            const bool isq = pn < 14; bf16_t* base = (bf16_t*)(ws + (isq ? WS_CQ : WS_CKV)); const int ld = isq ? QLR : KVLR, colt = isq ? (pn - 12) * 256 + cl : cl; float* ssq = (float*)(ws + (isq ? WS_SSQQ : WS_SSQKV));
#pragma unroll
            for (int ai = 0; ai < 2; ++ai)
#pragma unroll
                for (int m = 0; m < 4; ++m) { const int row = row0 + ai * 128 + m * 16; bf16_t* rowp = base + (size_t)row * ld + colt; float s = 0.f;
#pragma unroll
                    for (int bj = 0; bj < 2; ++bj) { const f32x4 a = acc[ai][bj][m][0], b = acc[ai][bj][m][1];
                        s += (a[0] * a[0] + a[1] * a[1]) + (a[2] * a[2] + a[3] * a[3]) + (b[0] * b[0] + b[1] * b[1]) + (b[2] * b[2] + b[3] * b[3]);
                        *(u32x4*)(rowp + bj * 128) = pack8(a, b); }
                    s += __shfl_xor(s, 16); s += __shfl_xor(s, 32);
                    if (fq == 0) atomicAdd(ssq + row, s); }
        } else {
            if (wc < 2) {
#pragma unroll
                for (int ai = 0; ai < 2; ++ai)
#pragma unroll
                    for (int m = 0; m < 4; ++m) { const int row = row0 + ai * 128 + m * 16; const int i0 = cl >> 1;
                        const f32x4 cs = *(const f32x4*)(COS + (size_t)row * 32 + i0), sn = *(const f32x4*)(SIN + (size_t)row * 32 + i0);
                        f32x4 a = acc[ai][0][m][0], b = acc[ai][0][m][1]; rope8(a, b, cs, sn); const u32x4 w = pack8(a, b);
                        bf16_t* rowp = KB + (size_t)row * NQB + 128 + cl;
#pragma unroll
                        for (int h = 0; h < 8; ++h) *(u32x4*)(rowp + h * 192) = w; }
                float mxr = 0.f;
#pragma unroll
                for (int ai = 0; ai < 2; ++ai)
#pragma unroll
                    for (int m = 0; m < 4; ++m) { float q = sq8f(acc[ai][0][m][0], acc[ai][0][m][1]); q += __shfl_xor(q, 16); q += __shfl_xor(q, 32); mxr = fmaxf(mxr, q); }
                mxr = fr_max(mxr); if (fr == 0 && fq == 0) atomicMax((unsigned*)(ws + WS_KMXR) + wc, __float_as_uint(mxr));
            }
        }
    }
};
struct EpiQB {
    static constexpr bool PERM = true;
    bf16_t* QB; const float *SSQ, *COS, *SIN;
    __device__ __forceinline__ void operator()(const f32x4 (&acc)[2][2][4][2], const Unit& u, int wr, int wc, int fr, int fq) const {
        const int row0 = u.pm * 256 + wr * 64 + fr;
#pragma unroll
        for (int ai = 0; ai < 2; ++ai)
#pragma unroll
            for (int m = 0; m < 4; ++m) { const int row = row0 + ai * 128 + m * 16; const float rstd = rsqrtf(SSQ[row] * (1.f / QLR) + EPS) * (0.07216878364870322f * LOG2E);
#pragma unroll
                for (int bj = 0; bj < 2; ++bj) { const int colw = u.pn * 256 + bj * 128 + wc * 32, hw = colw / 192, w = colw - hw * 192, col = colw + 8 * fq;
                    f32x4 a = acc[ai][bj][m][0] * rstd, b = acc[ai][bj][m][1] * rstd;
                    if (w >= 128) { const int i0 = ((w - 128) >> 1) + 4 * fq;
                        const f32x4 cs = *(const f32x4*)(COS + (size_t)row * 32 + i0), sn = *(const f32x4*)(SIN + (size_t)row * 32 + i0); rope8(a, b, cs, sn); }
                    *(u32x4*)(QB + (size_t)row * NQB + col) = pack8(a, b); } }
    }
};
struct EpiKV {
    static constexpr bool PERM = true;
    bf16_t *KB, *VB; const float* SSQ; unsigned* KMX;
    __device__ __forceinline__ void operator()(const f32x4 (&acc)[2][2][4][2], const Unit& u, int wr, int wc, int fr, int fq) const {
        const int row0 = u.pm * 256 + wr * 64 + fr, h = u.pn, cl = wc * 32 + 8 * fq; float mx = 0.f;
#pragma unroll
        for (int ai = 0; ai < 2; ++ai)
#pragma unroll
            for (int m = 0; m < 4; ++m) { const int row = row0 + ai * 128 + m * 16; const float rstd = rsqrtf(SSQ[row] * (1.f / KVLR) + EPS);
                { float q = sq8f(acc[ai][0][m][0] * rstd, acc[ai][0][m][1] * rstd); q += __shfl_xor(q, 16); q += __shfl_xor(q, 32); mx = fmaxf(mx, q); }
                *(u32x4*)(KB + (size_t)row * NQB + h * 192 + cl) = pack8(acc[ai][0][m][0] * rstd, acc[ai][0][m][1] * rstd);
                *(u32x4*)(VB + (size_t)row * 1024 + h * 128 + cl) = pack8(acc[ai][1][m][0] * rstd, acc[ai][1][m][1] * rstd); }
        mx = fr_max(mx); if (fr == 0 && fq == 0) atomicMax(KMX + h * 4 + wc, __float_as_uint(mx));
    }
};
struct EpiRes {
    static constexpr bool PERM = false;
    const float* base; float* out;
    __device__ __forceinline__ void operator()(const f32x4 (&acc)[2][2][4][2], const Unit& u, int wr, int wc, int fr, int fq) const {
        const int row0 = u.pm * 256 + wr * 64 + fr, col0 = u.pn * 256 + wc * 32 + 4 * fq;
#pragma unroll
        for (int ai = 0; ai < 2; ++ai)
#pragma unroll
            for (int m = 0; m < 4; ++m) { const size_t off = (size_t)(row0 + ai * 128 + m * 16) * DM + col0;
#pragma unroll
                for (int bj = 0; bj < 2; ++bj)
#pragma unroll
                    for (int n = 0; n < 2; ++n) { const f32x4 bs = *(const f32x4*)(base + off + bj * 128 + n * 16); *(f32x4*)(out + off + bj * 128 + n * 16) = bs + acc[ai][bj][m][n]; } }
    }
};
struct EpiGU {
    static constexpr bool PERM = true;
    bf16_t* ACT;
    __device__ __forceinline__ void operator()(const f32x4 (&acc)[2][2][4][2], const Unit& u, int wr, int wc, int fr, int fq) const {
        const int row0 = u.pm * 256 + wr * 64 + fr, col = u.pn * 128 + wc * 32 + 8 * fq;
#pragma unroll
        for (int ai = 0; ai < 2; ++ai)
#pragma unroll
            for (int m = 0; m < 4; ++m) { f32x4 r[2];
#pragma unroll
                for (int n = 0; n < 2; ++n) { const f32x4 g = acc[ai][0][m][n], up = acc[ai][1][m][n];
#pragma unroll
                    for (int j = 0; j < 4; ++j) r[n][j] = g[j] * up[j] * __builtin_amdgcn_rcpf(1.f + __builtin_amdgcn_exp2f(-g[j] * LOG2E)); }
                *(u32x4*)(ACT + (size_t)(row0 + ai * 128 + m * 16) * DFF + col) = pack8(r[0], r[1]); }
    }
};

namespace att {
constexpr int NW = 8, QBLK = 32, KVBLK = 64;
constexpr float THR2 = 8.f * LOG2E;
constexpr int SHM_V = KVBLK * 128 * 2;
constexpr int OFF_K = 2 * SHM_V, OFF_WS = OFF_K + 2 * 64 * 192 * 2, OFF_TBL = OFF_WS + NW * 256, OFF_QL = OFF_TBL + 2048, ATT_LDS = OFF_QL + NW * 8192;
constexpr int OFF_KA = 65536, OFF_WSA = 98304, OFF_TBLA = 100352;
constexpr int OFF_K3 = 3 * SHM_V, OFF_WS3 = OFF_K3 + 3 * 24576, OFF_TBL3 = OFF_WS3 + NW * 256;
#ifdef NO_SBAR
#define SBAR() do {} while (0)
#else
#define SBAR() __builtin_amdgcn_sched_barrier(0)
#endif
__device__ __forceinline__ int crow(int r, int hi) { return (r & 3) + 8 * (r >> 2) + 4 * hi; }
template <int DQK> __device__ __forceinline__ int koff(int row, int c) { const int s = ((row >> 1) & 1) | (((row >> 3) & 3) << 1); return row * (DQK * 2) + ((c ^ s) << 4); }
__device__ __forceinline__ int v_st(int k, int c) { const int kk = (k & ~0xC) | ((k & 4) << 1) | ((k & 8) >> 1); return ((kk >> 3) * 4 + (c >> 5)) * 512 + ((kk & 7) * 32 + (c & 31)) * 2; }
__device__ __forceinline__ int v_rd_base(int lane) { return ((lane & 3) << 3) | (((lane >> 2) & 3) << 6) | (((lane >> 4) & 1) << 5) | (((lane >> 5) & 1) << 8); }
constexpr int v_rd_off(int d0, int ks, int half) { return d0 * 512 + ks * 4096 + half * 2048; }
template <int OFF> __device__ __forceinline__ s16x4 tr_read(int vb) { s16x4 r; asm volatile("ds_read_b64_tr_b16 %0, %1 offset:%2" : "=&v"(r) : "v"(vb), "i"(OFF) : "memory"); return r; }
template <int D0> __device__ __forceinline__ void pv_one(f32x16& od, int vb, bf16x8 pa0, bf16x8 pa1, bf16x8 pa2, bf16x8 pa3) {
    s16x4 l0 = tr_read<v_rd_off(D0, 0, 0)>(vb), h0 = tr_read<v_rd_off(D0, 0, 1)>(vb), l1 = tr_read<v_rd_off(D0, 1, 0)>(vb), h1 = tr_read<v_rd_off(D0, 1, 1)>(vb);
    s16x4 l2 = tr_read<v_rd_off(D0, 2, 0)>(vb), h2 = tr_read<v_rd_off(D0, 2, 1)>(vb), l3 = tr_read<v_rd_off(D0, 3, 0)>(vb), h3 = tr_read<v_rd_off(D0, 3, 1)>(vb);
#ifdef NO_SBAR
    asm volatile("s_waitcnt lgkmcnt(0)" : "+v"(l0), "+v"(h0), "+v"(l1), "+v"(h1), "+v"(l2), "+v"(h2), "+v"(l3), "+v"(h3) :: "memory");
#else
    asm volatile("s_waitcnt lgkmcnt(0)" ::: "memory"); SBAR();
#endif
#define PK(L, H) (bf16x8){L[0], L[1], L[2], L[3], H[0], H[1], H[2], H[3]}
    od = __builtin_amdgcn_mfma_f32_32x32x16_bf16(pa0, PK(l0, h0), od, 0, 0, 0);
    od = __builtin_amdgcn_mfma_f32_32x32x16_bf16(pa1, PK(l1, h1), od, 0, 0, 0);
    od = __builtin_amdgcn_mfma_f32_32x32x16_bf16(pa2, PK(l2, h2), od, 0, 0, 0);
    od = __builtin_amdgcn_mfma_f32_32x32x16_bf16(pa3, PK(l3, h3), od, 0, 0, 0);
#undef PK
}
__device__ __forceinline__ void pv_d0(f32x16 (&o)[4], int vb, bf16x8 pa0, bf16x8 pa1, bf16x8 pa2, bf16x8 pa3) {
    pv_one<0>(o[0], vb, pa0, pa1, pa2, pa3); pv_one<1>(o[1], vb, pa0, pa1, pa2, pa3); pv_one<2>(o[2], vb, pa0, pa1, pa2, pa3); pv_one<3>(o[3], vb, pa0, pa1, pa2, pa3);
}
template <bool BAND>
__device__ __forceinline__ void partialSM(f32x16& p0, f32x16& p1, float& m_reg, float& mn, float& alpha, float C, float cb, const LAS float* tbl, int relb, int hi) {
    if constexpr (BAND) {
#pragma unroll
        for (int r = 0; r < 16; ++r) { int i0 = relb + crow(r, hi), i1 = i0 + 32; i0 = min(max(i0, 0), 256); i1 = min(max(i1, 0), 256);
            p0[r] = fmaf(p0[r], C, tbl[i0]); p1[r] = fmaf(p1[r], C, tbl[i1]); }
    }
    float pmax = p0[0];
#pragma unroll
    for (int r = 1; r < 16; ++r) pmax = fmaxf(pmax, p0[r]);
#pragma unroll
    for (int r = 0; r < 16; ++r) pmax = fmaxf(pmax, p1[r]);
    { auto rr = __builtin_amdgcn_permlane32_swap(__float_as_uint(pmax), __float_as_uint(pmax), false, false);
      pmax = fmaxf(__uint_as_float(rr[0]), __uint_as_float(rr[1])); }
    const float ymax = BAND ? pmax : fmaf(pmax, C, cb);
    if (__builtin_expect(__all(ymax - m_reg <= THR2), 1)) { mn = m_reg; alpha = 1.f; }
    else { mn = fmaxf(m_reg, ymax); alpha = __builtin_amdgcn_exp2f(m_reg - mn); m_reg = mn; }
    if constexpr (BAND) {
#pragma unroll
        for (int r = 0; r < 16; ++r) { p0[r] -= mn; p1[r] -= mn; }
    } else {
        const float a = cb - mn;
#pragma unroll
        for (int r = 0; r < 16; ++r) { p0[r] = fmaf(p0[r], C, a); p1[r] = fmaf(p1[r], C, a); }
    }
#pragma unroll
    for (int r = 0; r < 16; ++r) p0[r] = __builtin_amdgcn_exp2f(p0[r]);
}
__device__ __forceinline__ void finishSM(f32x16& p0, f32x16& p1, float alpha, float& l_reg, bf16x8& pa0, bf16x8& pa1, bf16x8& pa2, bf16x8& pa3) {
#pragma unroll
    for (int r = 0; r < 16; ++r) p1[r] = __builtin_amdgcn_exp2f(p1[r]);
    float ps = 0;
#pragma unroll
    for (int r = 0; r < 16; ++r) ps += p0[r];
#pragma unroll
    for (int r = 0; r < 16; ++r) ps += p1[r];
    { auto rr = __builtin_amdgcn_permlane32_swap(__float_as_uint(ps), __float_as_uint(ps), false, false);
      ps = __uint_as_float(rr[0]) + __uint_as_float(rr[1]); }
    l_reg = l_reg * alpha + ps;
#define PK4(P, BASE, OUT) do { unsigned a0 = cvt_pk_bf16(P[BASE + 0], P[BASE + 1]), a1 = cvt_pk_bf16(P[BASE + 2], P[BASE + 3]);   \
    unsigned b0 = cvt_pk_bf16(P[BASE + 4], P[BASE + 5]), b1 = cvt_pk_bf16(P[BASE + 6], P[BASE + 7]);                              \
    auto r0 = __builtin_amdgcn_permlane32_swap(a0, b0, false, false); auto r1 = __builtin_amdgcn_permlane32_swap(a1, b1, false, false); \
    u32x4 w = {r0[0], r1[0], r0[1], r1[1]}; OUT = *reinterpret_cast<bf16x8*>(&w); } while (0)
    PK4(p0, 0, pa0); PK4(p0, 8, pa1); PK4(p1, 0, pa2); PK4(p1, 8, pa3);
#undef PK4
}
template <int DQK, int QREG>
__device__ __forceinline__ void qkt(f32x16& p0, f32x16& p1, const LAS unsigned char* Ks, const bf16x8 (&qr)[QREG], const LAS unsigned char* ql, int r32, int hi) {
    p0 = f32x16{}; p1 = f32x16{};
#pragma unroll
    for (int d0 = 0; d0 < DQK / 16; ++d0) { const int c = d0 * 2 + hi;
        const bf16x8 b0 = *(const LAS bf16x8*)(Ks + koff<DQK>(r32, c));
        const bf16x8 b1 = *(const LAS bf16x8*)(Ks + koff<DQK>(32 + r32, c));
        bf16x8 q; if (d0 < QREG) q = qr[d0 < QREG ? d0 : 0]; else q = *(const LAS bf16x8*)(ql + (d0 - QREG) * 1024);
        p0 = __builtin_amdgcn_mfma_f32_32x32x16_bf16(b0, q, p0, 0, 0, 0);
        p1 = __builtin_amdgcn_mfma_f32_32x32x16_bf16(b1, q, p1, 0, 0, 0); }
}

template <int OFF> __device__ __forceinline__ bf16x8 ldsr128(int addr) { bf16x8 r; asm volatile("ds_read_b128 %0, %1 offset:%2" : "=v"(r) : "v"(addr), "i"(OFF) : "memory"); return r; }
template <int BUF, int QREG>
__device__ __forceinline__ void qkt192(f32x16& p0, f32x16& p1, const int (&kb)[4], const bf16x8 (&qr)[QREG], const LAS unsigned char* ql) {
    p0 = f32x16{}; p1 = f32x16{};
#define QKT_G(G) do { \
        bf16x8 a0 = ldsr128<BUF * 24576 + 128 * G>(kb[0]), b0 = ldsr128<BUF * 24576 + 128 * G + 12288>(kb[0]); \
        bf16x8 a1 = ldsr128<BUF * 24576 + 128 * G>(kb[1]), b1 = ldsr128<BUF * 24576 + 128 * G + 12288>(kb[1]); \
        bf16x8 a2 = ldsr128<BUF * 24576 + 128 * G>(kb[2]), b2 = ldsr128<BUF * 24576 + 128 * G + 12288>(kb[2]); \
        bf16x8 a3 = ldsr128<BUF * 24576 + 128 * G>(kb[3]), b3 = ldsr128<BUF * 24576 + 128 * G + 12288>(kb[3]); \
        bf16x8 q0, q1, q2, q3; \
        if (4 * G + 0 < QREG) q0 = qr[4 * G + 0 < QREG ? 4 * G + 0 : 0]; else q0 = *(const LAS bf16x8*)(ql + (4 * G + 0 - QREG) * 1024); \
        if (4 * G + 1 < QREG) q1 = qr[4 * G + 1 < QREG ? 4 * G + 1 : 0]; else q1 = *(const LAS bf16x8*)(ql + (4 * G + 1 - QREG) * 1024); \
        if (4 * G + 2 < QREG) q2 = qr[4 * G + 2 < QREG ? 4 * G + 2 : 0]; else q2 = *(const LAS bf16x8*)(ql + (4 * G + 2 - QREG) * 1024); \
        if (4 * G + 3 < QREG) q3 = qr[4 * G + 3 < QREG ? 4 * G + 3 : 0]; else q3 = *(const LAS bf16x8*)(ql + (4 * G + 3 - QREG) * 1024); \
        asm volatile("s_waitcnt lgkmcnt(0)" : "+v"(a0), "+v"(b0), "+v"(a1), "+v"(b1), "+v"(a2), "+v"(b2), "+v"(a3), "+v"(b3) :: "memory"); \
        p0 = __builtin_amdgcn_mfma_f32_32x32x16_bf16(a0, q0, p0, 0, 0, 0); p1 = __builtin_amdgcn_mfma_f32_32x32x16_bf16(b0, q0, p1, 0, 0, 0); \
        p0 = __builtin_amdgcn_mfma_f32_32x32x16_bf16(a1, q1, p0, 0, 0, 0); p1 = __builtin_amdgcn_mfma_f32_32x32x16_bf16(b1, q1, p1, 0, 0, 0); \
        p0 = __builtin_amdgcn_mfma_f32_32x32x16_bf16(a2, q2, p0, 0, 0, 0); p1 = __builtin_amdgcn_mfma_f32_32x32x16_bf16(b2, q2, p1, 0, 0, 0); \
        p0 = __builtin_amdgcn_mfma_f32_32x32x16_bf16(a3, q3, p0, 0, 0, 0); p1 = __builtin_amdgcn_mfma_f32_32x32x16_bf16(b3, q3, p1, 0, 0, 0); } while (0)
    QKT_G(0); QKT_G(1); QKT_G(2);
#undef QKT_G
}
template <int DQK, bool BIAS, int ldq, int ldk, int ldv, int SDEPTH, int QREG>
__device__ __forceinline__ void attn_body(const bf16_t* __restrict__ Qb, const bf16_t* __restrict__ Kh, const bf16_t* __restrict__ Vh,
                                          LAS unsigned char* lds, float C, int q0, float cb_lo, float cb_hi, f32x16 (&o)[4]) {
    constexpr int NK = DQK / 64, CPR = DQK / 8, SHM_K = 64 * DQK * 2, NLD = 2 + NK;
    int tid_ = threadIdx.x; asm volatile("" : "+v"(tid_));
    const int tid = tid_, wid = tid >> 6, lane = tid & 63, r32 = lane & 31, hi = lane >> 5;
    LAS unsigned char* V_lds = lds; LAS unsigned char* K_lds = lds + OFF_K;
    LAS float* ws = (LAS float*)(lds + OFF_WS) + wid * 64; LAS float* li_l = ws; LAS float* al_l = ws + 32;
    const LAS float* tbl = (const LAS float*)(lds + OFF_TBL);
    float m_reg = -1e30f, l_reg = 0;
#pragma unroll
    for (int d = 0; d < 4; ++d) o[d] = f32x16{};
    bf16x8 qr[QREG];
    const bf16_t* Qw = Qb + (size_t)(wid * QBLK + r32) * ldq + hi * 8;
    LAS unsigned char* ql = lds + OFF_QL + wid * 8192 + lane * 16;
#pragma unroll
    for (int d0 = 0; d0 < DQK / 16; ++d0) { const bf16x8 q = *(const bf16x8*)(Qw + d0 * 16); if (d0 < QREG) qr[d0 < QREG ? d0 : 0] = q; else *(LAS bf16x8*)(ql + (d0 - QREG) * 1024) = q; }
    const int sr = tid >> 4, sc = (tid & 15) * 8, vst0 = v_st(sr, sc), vst1 = vst0 + 8192;
    unsigned kgo[NK]; int klo[NK];
#pragma unroll
    for (int i = 0; i < NK; ++i) { const int id = tid + 512 * i, row = id / CPR, c = id - row * CPR; kgo[i] = (unsigned)(row * ldk + c * 8) * 2u; klo[i] = koff<DQK>(row, c); }
    const unsigned vgo0 = (unsigned)(sr * ldv + sc) * 2u, vgo1 = vgo0 + (unsigned)(32 * ldv * 2);
    const int vb0 = (int)(uintptr_t)V_lds + v_rd_base(lane);
    int kb4[4];
#pragma unroll
    for (int e = 0; e < 4; ++e) kb4[e] = (int)(uintptr_t)K_lds + koff<DQK>(r32, 2 * e + hi);
#define QKT(P0, P1, BUF) do { if constexpr (DQK == 192) qkt192<BUF, QREG>(P0, P1, kb4, qr, ql); else qkt<DQK, QREG>(P0, P1, K_lds + BUF * SHM_K, qr, ql, r32, hi); } while (0)
    struct Slot { bf16x8 v0, v1, k[NK]; } slots[SDEPTH];
#define sl0 slots[0]
#define sl1 slots[SDEPTH - 1]
    const int qabs = q0 + wid * QBLK + r32;
#define SLOAD(sl, k0) do { const char* vb_ = (const char*)(Vh + (size_t)(k0) * ldv); const char* kb_ = (const char*)(Kh + (size_t)(k0) * ldk); \
    sl.v0 = *(const bf16x8*)(vb_ + vgo0); sl.v1 = *(const bf16x8*)(vb_ + vgo1); \
    _Pragma("unroll") for (int _i = 0; _i < NK; ++_i) sl.k[_i] = *(const bf16x8*)(kb_ + kgo[_i]); } while (0)
#define SWRITE(b, sl) do { *(LAS bf16x8*)(V_lds + (b) * SHM_V + vst0) = sl.v0; *(LAS bf16x8*)(V_lds + (b) * SHM_V + vst1) = sl.v1; \
    _Pragma("unroll") for (int _i = 0; _i < NK; ++_i) *(LAS bf16x8*)(K_lds + (b) * SHM_K + klo[_i]) = sl.k[_i]; } while (0)
#define SWAIT() do { if constexpr (SDEPTH == 1) asm volatile("s_waitcnt vmcnt(0)" ::: "memory"); else if constexpr (NLD == 3) asm volatile("s_waitcnt vmcnt(3)" ::: "memory"); else asm volatile("s_waitcnt vmcnt(5)" ::: "memory"); } while (0)
#define RESC(a) do { if (__any((a) < 1.f)) { if (hi == 0) al_l[r32] = (a); asm volatile("s_waitcnt lgkmcnt(0)" ::: "memory"); \
    _Pragma("unroll") for (int d = 0; d < 4; ++d) _Pragma("unroll") for (int r = 0; r < 16; ++r) o[d][r] *= al_l[crow(r, hi)]; } } while (0)
#define PSM(P0, P1, MN, AL, t) do { if constexpr (BIAS) { const int k0_ = (t) * KVBLK; \
        if (k0_ <= q0 - 191 || k0_ >= q0 + 383) partialSM<false>(P0, P1, m_reg, MN, AL, C, k0_ < q0 ? cb_lo : cb_hi, tbl, 0, hi); \
        else partialSM<true>(P0, P1, m_reg, MN, AL, C, 0.f, tbl, k0_ - qabs + 128, hi); } \
      else partialSM<false>(P0, P1, m_reg, MN, AL, C, 0.f, tbl, 0, hi); } while (0)
    f32x16 pA0, pA1, pB0, pB1; float mnA, mnB, alA, alB; bf16x8 pa0, pa1, pa2, pa3; const int NT = S / KVBLK;
    if (wid >= 4) __builtin_amdgcn_s_setprio(1);
    SLOAD(sl0, 0); asm volatile("s_waitcnt vmcnt(0)" ::: "memory"); SWRITE(0, sl0); __syncthreads();
    QKT(pA0, pA1, 0); PSM(pA0, pA1, mnA, alA, 0);
    SLOAD(sl1, KVBLK); if constexpr (SDEPTH == 2) SLOAD(sl0, 2 * KVBLK);
    SWAIT(); SWRITE(1, sl1); __syncthreads();
    for (int j = 1; j + 1 < NT; j += 2) {
        SBAR(); QKT(pB0, pB1, 1);
        finishSM(pA0, pA1, alA, l_reg, pa0, pa1, pa2, pa3); SBAR();
        SLOAD(sl1, (j + SDEPTH) * KVBLK); SBAR();
        pv_d0(o, vb0, pa0, pa1, pa2, pa3); PSM(pB0, pB1, mnB, alB, j);
        __syncthreads(); SWAIT(); SWRITE(0, sl0);
        RESC(alB); __syncthreads();
        SBAR(); QKT(pA0, pA1, 0);
        finishSM(pB0, pB1, alB, l_reg, pa0, pa1, pa2, pa3); SBAR();
        if (SDEPTH == 1 || j + 3 < NT) SLOAD(sl0, (j + 1 + SDEPTH) * KVBLK); SBAR();
        pv_d0(o, vb0 + SHM_V, pa0, pa1, pa2, pa3); PSM(pA0, pA1, mnA, alA, j + 1);
        __syncthreads(); SWAIT(); SWRITE(1, sl1);
        RESC(alA); __syncthreads();
    }
    SBAR(); QKT(pB0, pB1, 1);
    finishSM(pA0, pA1, alA, l_reg, pa0, pa1, pa2, pa3); SBAR();
    pv_d0(o, vb0, pa0, pa1, pa2, pa3); PSM(pB0, pB1, mnB, alB, NT - 1);
    __syncthreads(); RESC(alB);
    finishSM(pB0, pB1, alB, l_reg, pa0, pa1, pa2, pa3); SBAR();
    pv_d0(o, vb0 + SHM_V, pa0, pa1, pa2, pa3);
    __builtin_amdgcn_s_setprio(0);
    if (hi == 0) li_l[r32] = l_reg; asm volatile("s_waitcnt lgkmcnt(0)" ::: "memory");
#pragma unroll
    for (int r = 0; r < 16; ++r) { const float rl = __builtin_amdgcn_rcpf(li_l[crow(r, hi)]);
#pragma unroll
        for (int d = 0; d < 4; ++d) o[d][r] *= rl; }
#undef SLOAD
#undef sl0
#undef sl1
#undef SWRITE
#undef SWAIT
#undef RESC
#undef PSM
#undef QKT
}

template <int DQK, bool BIAS, int ldq, int ldk, int ldv, int QREG>
__device__ __forceinline__ void attn_body1(const bf16_t* __restrict__ Qb, const bf16_t* __restrict__ Kh, const bf16_t* __restrict__ Vh,
                                           LAS unsigned char* lds, float C, int q0, float cb_lo, float cb_hi, f32x16 (&o)[4]) {
    constexpr int NK = DQK / 64, CPR = DQK / 8, SHM_K = 64 * DQK * 2;
    int tid_ = threadIdx.x; asm volatile("" : "+v"(tid_));
    const int tid = tid_, wid = tid >> 6, lane = tid & 63, r32 = lane & 31, hi = lane >> 5;
    LAS unsigned char* V_lds = lds; LAS unsigned char* K_lds = lds + OFF_K;
    LAS float* ws = (LAS float*)(lds + OFF_WS) + wid * 64; LAS float* li_l = ws; LAS float* al_l = ws + 32;
    const LAS float* tbl = (const LAS float*)(lds + OFF_TBL);
    float m_reg = -1e30f, l_reg = 0;
#pragma unroll
    for (int d = 0; d < 4; ++d) o[d] = f32x16{};
    bf16x8 qr[QREG];
    const bf16_t* Qw = Qb + (size_t)(wid * QBLK + r32) * ldq + hi * 8;
    LAS unsigned char* ql = lds + OFF_QL + wid * 8192 + lane * 16;
#pragma unroll
    for (int d0 = 0; d0 < DQK / 16; ++d0) { const bf16x8 q = *(const bf16x8*)(Qw + d0 * 16); if (d0 < QREG) qr[d0 < QREG ? d0 : 0] = q; else *(LAS bf16x8*)(ql + (d0 - QREG) * 1024) = q; }
    const int sr = tid >> 4, sc = (tid & 15) * 8, vst0 = v_st(sr, sc), vst1 = vst0 + 8192;
    unsigned kgo[NK]; int klo[NK];
#pragma unroll
    for (int i = 0; i < NK; ++i) { const int id = tid + 512 * i, row = id / CPR, c = id - row * CPR; kgo[i] = (unsigned)(row * ldk + c * 8) * 2u; klo[i] = koff<DQK>(row, c); }
    const unsigned vgo0 = (unsigned)(sr * ldv + sc) * 2u, vgo1 = vgo0 + (unsigned)(32 * ldv * 2);
    const int vb0 = (int)(uintptr_t)V_lds + v_rd_base(lane);
    bf16x8 sv0, sv1, sk[NK];
    const int qabs = q0 + wid * QBLK + r32;
#define SLOAD1(k0) do { const char* vb_ = (const char*)(Vh + (size_t)(k0) * ldv); const char* kb_ = (const char*)(Kh + (size_t)(k0) * ldk); \
    sv0 = *(const bf16x8*)(vb_ + vgo0); sv1 = *(const bf16x8*)(vb_ + vgo1); \
    _Pragma("unroll") for (int _i = 0; _i < NK; ++_i) sk[_i] = *(const bf16x8*)(kb_ + kgo[_i]); } while (0)
#define SWRITE1(b) do { *(LAS bf16x8*)(V_lds + (b) * SHM_V + vst0) = sv0; *(LAS bf16x8*)(V_lds + (b) * SHM_V + vst1) = sv1; \
    _Pragma("unroll") for (int _i = 0; _i < NK; ++_i) *(LAS bf16x8*)(K_lds + (b) * SHM_K + klo[_i]) = sk[_i]; } while (0)
    constexpr int NT = S / KVBLK;
    if (wid >= 4) __builtin_amdgcn_s_setprio(1);
    SLOAD1(0); asm volatile("s_waitcnt vmcnt(0)" ::: "memory"); SWRITE1(0); __syncthreads();
    for (int j = 0; j < NT; ++j) {
        const int b = j & 1;
        if (j + 1 < NT) SLOAD1((j + 1) * KVBLK);
        f32x16 p0, p1; float mn, al; bf16x8 pa0, pa1, pa2, pa3;
        qkt<DQK, QREG>(p0, p1, K_lds + b * SHM_K, qr, ql, r32, hi);
        if constexpr (BIAS) { const int k0_ = j * KVBLK;
            if (k0_ <= q0 - 191) partialSM<false>(p0, p1, m_reg, mn, al, C, cb_lo, tbl, 0, hi);
            else if (k0_ >= q0 + 383) partialSM<false>(p0, p1, m_reg, mn, al, C, cb_hi, tbl, 0, hi);
            else partialSM<true>(p0, p1, m_reg, mn, al, C, 0.f, tbl, k0_ - qabs + 128, hi); }
        else partialSM<false>(p0, p1, m_reg, mn, al, C, 0.f, tbl, 0, hi);
        finishSM(p0, p1, al, l_reg, pa0, pa1, pa2, pa3);
        if (__any(al < 1.f)) { if (hi == 0) al_l[r32] = al; asm volatile("s_waitcnt lgkmcnt(0)" ::: "memory");
#pragma unroll
            for (int d = 0; d < 4; ++d)
#pragma unroll
                for (int r = 0; r < 16; ++r) o[d][r] *= al_l[crow(r, hi)]; }
        pv_d0(o, vb0 + b * SHM_V, pa0, pa1, pa2, pa3);
        if (j + 1 < NT) SWRITE1(b ^ 1);
        __syncthreads();
    }
    __builtin_amdgcn_s_setprio(0);
    if (hi == 0) li_l[r32] = l_reg; asm volatile("s_waitcnt lgkmcnt(0)" ::: "memory");
#pragma unroll
    for (int r = 0; r < 16; ++r) { const float rl = __builtin_amdgcn_rcpf(li_l[crow(r, hi)]);
#pragma unroll
        for (int d = 0; d < 4; ++d) o[d][r] *= rl; }
#undef SLOAD1
#undef SWRITE1
}


template <int BUF>
__device__ __forceinline__ void qkt192n(f32x16& p0, f32x16& p1, const int (&kb)[4], const bf16x8 (&qr)[12], const f32x16& nm) {
#define QKT_G(G) do { \
        bf16x8 a0 = ldsr128<BUF * 24576 + 128 * G>(kb[0]), b0 = ldsr128<BUF * 24576 + 128 * G + 12288>(kb[0]); \
        bf16x8 a1 = ldsr128<BUF * 24576 + 128 * G>(kb[1]), b1 = ldsr128<BUF * 24576 + 128 * G + 12288>(kb[1]); \
        bf16x8 a2 = ldsr128<BUF * 24576 + 128 * G>(kb[2]), b2 = ldsr128<BUF * 24576 + 128 * G + 12288>(kb[2]); \
        bf16x8 a3 = ldsr128<BUF * 24576 + 128 * G>(kb[3]), b3 = ldsr128<BUF * 24576 + 128 * G + 12288>(kb[3]); \
        asm volatile("s_waitcnt lgkmcnt(0)" : "+v"(a0), "+v"(b0), "+v"(a1), "+v"(b1), "+v"(a2), "+v"(b2), "+v"(a3), "+v"(b3) :: "memory"); \
        p0 = __builtin_amdgcn_mfma_f32_32x32x16_bf16(a0, qr[4 * G + 0], G == 0 ? nm : p0, 0, 0, 0); p1 = __builtin_amdgcn_mfma_f32_32x32x16_bf16(b0, qr[4 * G + 0], G == 0 ? nm : p1, 0, 0, 0); \
        p0 = __builtin_amdgcn_mfma_f32_32x32x16_bf16(a1, qr[4 * G + 1], p0, 0, 0, 0); p1 = __builtin_amdgcn_mfma_f32_32x32x16_bf16(b1, qr[4 * G + 1], p1, 0, 0, 0); \
        p0 = __builtin_amdgcn_mfma_f32_32x32x16_bf16(a2, qr[4 * G + 2], p0, 0, 0, 0); p1 = __builtin_amdgcn_mfma_f32_32x32x16_bf16(b2, qr[4 * G + 2], p1, 0, 0, 0); \
        p0 = __builtin_amdgcn_mfma_f32_32x32x16_bf16(a3, qr[4 * G + 3], p0, 0, 0, 0); p1 = __builtin_amdgcn_mfma_f32_32x32x16_bf16(b3, qr[4 * G + 3], p1, 0, 0, 0); } while (0)
    QKT_G(0); QKT_G(1); QKT_G(2);
#undef QKT_G
}
__device__ __forceinline__ float sq8(u32x4 w) {
    float s = 0.f;
#pragma unroll
    for (int e = 0; e < 4; ++e) { const float lo = __uint_as_float(w[e] << 16), hi = __uint_as_float(w[e] & 0xffff0000u); s = fmaf(lo, lo, s); s = fmaf(hi, hi, s); }
    return s;
}
template <int DQK, bool BIAS, int ldq, int ldk, int ldv>
__device__ __forceinline__ void attn_f(const bf16_t* __restrict__ Qb, const bf16_t* __restrict__ Kh, const bf16_t* __restrict__ Vh,
                                       LAS unsigned char* lds, int q0, float cb_lo, float cb_hi, float kmax, float bmax, f32x16 (&o)[4]) {
    constexpr int RING = (DQK == 192) ? 3 : 2;
    constexpr int NK = DQK / 64, CPR = DQK / 8, SHM_K = (RING == 3) ? 24576 : 64 * DQK * 2, QREG = DQK / 16, NT = S / KVBLK;
    constexpr bool KPERM = (DQK == 64);
    int tid_ = threadIdx.x; asm volatile("" : "+v"(tid_));
    const int tid = tid_, wid = __builtin_amdgcn_readfirstlane(tid >> 6), lane = tid & 63, r32 = lane & 31, hi = lane >> 5;
    LAS unsigned char* V_lds = lds; LAS unsigned char* K_lds = lds + (RING == 3 ? OFF_K3 : OFF_K);
    LAS float* ws = (LAS float*)(lds + (RING == 3 ? OFF_WS3 : OFF_WS)) + wid * 64; LAS float* li_l = ws;
    const LAS float* tbl = (const LAS float*)(lds + OFF_TBL);
    float l_reg = 0.f;
#pragma unroll
    for (int d = 0; d < 4; ++d) o[d] = f32x16{};
    bf16x8 qr[QREG];
    const bf16_t* Qw = Qb + (size_t)(wid * QBLK + r32) * ldq + hi * 8;
    float qs = 0.f;
#pragma unroll
    for (int d0 = 0; d0 < QREG; ++d0) { qr[d0] = *(const bf16x8*)(Qw + d0 * 16); qs += sq8(__builtin_bit_cast(u32x4, qr[d0])); }
    { auto rr = __builtin_amdgcn_permlane32_swap(__float_as_uint(qs), __float_as_uint(qs), false, false); qs = __uint_as_float(rr[0]) + __uint_as_float(rr[1]); }
    const float nm_ref = -(sqrtf(qs) * kmax + bmax);
    f32x16 nm;
#pragma unroll
    for (int r = 0; r < 16; ++r) nm[r] = nm_ref;
    unsigned kgo[NK], vgo[2];
#pragma unroll
    for (int i = 0; i < NK; ++i) { const int p = (i * 8 + wid) * 64 + lane, rho = p / CPR, cph = p - rho * CPR, sw = ((rho >> 1) & 1) | (((rho >> 3) & 3) << 1), c = cph ^ sw;
        const int k = KPERM ? ((rho & ~0xC) | ((rho & 4) << 1) | ((rho & 8) >> 1)) : rho; kgo[i] = (unsigned)(k * ldk + c * 8) * 2u; }
#pragma unroll
    for (int i = 0; i < 2; ++i) { const int p = (i * 8 + wid) * 64 + lane, sub = p >> 5, w = p & 31, kk = (sub >> 2) * 8 + (w >> 2), k = (kk & ~0xC) | ((kk & 4) << 1) | ((kk & 8) >> 1), col = (sub & 3) * 32 + (w & 3) * 8;
        vgo[i] = (unsigned)(k * ldv + col) * 2u; }
    const int vb0 = (int)(uintptr_t)V_lds + v_rd_base(lane);
    const int qabs = q0 + wid * QBLK + r32;
    int kb4[4];
#pragma unroll
    for (int e = 0; e < 4; ++e) kb4[e] = (int)(uintptr_t)K_lds + koff<DQK>(r32, 2 * e + hi);
    const __amdgpu_buffer_rsrc_t krs = __builtin_amdgcn_make_buffer_rsrc((void*)Kh, 0, 0x7fffffff, 0x00020000), vrs = __builtin_amdgcn_make_buffer_rsrc((void*)Vh, 0, 0x7fffffff, 0x00020000);
#define DMA2(t, KB_, VB_) do { const int ko_ = (t) * (KVBLK * ldk * 2), vo_ = (t) * (KVBLK * ldv * 2); \
    _Pragma("unroll") for (int _i = 0; _i < NK; ++_i) __builtin_amdgcn_raw_ptr_buffer_load_lds(krs, (LAS void*)(K_lds + (KB_) + (_i * 8 + wid) * 1024), 16, kgo[_i], ko_, 0, 0); \
    _Pragma("unroll") for (int _i = 0; _i < 2; ++_i) __builtin_amdgcn_raw_ptr_buffer_load_lds(vrs, (LAS void*)(V_lds + (VB_) + (_i * 8 + wid) * 1024), 16, vgo[_i], vo_, 0, 0); } while (0)
#define PK4(P, BASE, OUT) do { if constexpr (KPERM) { u32x4 w = {cvt_pk_bf16(P[BASE + 0], P[BASE + 1]), cvt_pk_bf16(P[BASE + 2], P[BASE + 3]), cvt_pk_bf16(P[BASE + 4], P[BASE + 5]), cvt_pk_bf16(P[BASE + 6], P[BASE + 7])}; \
        OUT = *reinterpret_cast<bf16x8*>(&w); } else { unsigned a0 = cvt_pk_bf16(P[BASE + 0], P[BASE + 1]), a1 = cvt_pk_bf16(P[BASE + 2], P[BASE + 3]), b0_ = cvt_pk_bf16(P[BASE + 4], P[BASE + 5]), b1_ = cvt_pk_bf16(P[BASE + 6], P[BASE + 7]); \
        auto r0 = __builtin_amdgcn_permlane32_swap(a0, b0_, false, false); auto r1 = __builtin_amdgcn_permlane32_swap(a1, b1_, false, false); \
        u32x4 w = {r0[0], r1[0], r0[1], r1[1]}; OUT = *reinterpret_cast<bf16x8*>(&w); } } while (0)
#define TILEC(KB_, VB_, t, QKB, BANDTILE) do { \
        f32x16 p0, p1; \
        if constexpr (DQK == 192) qkt192n<QKB>(p0, p1, kb4, qr, nm); else \
        { const LAS unsigned char* Ks = K_lds + (KB_); \
          _Pragma("unroll") for (int d0 = 0; d0 < DQK / 16; ++d0) { const int c = d0 * 2 + hi; \
              const bf16x8 b0 = *(const LAS bf16x8*)(Ks + koff<DQK>(r32, c)); const bf16x8 b1 = *(const LAS bf16x8*)(Ks + koff<DQK>(32 + r32, c)); \
              p0 = __builtin_amdgcn_mfma_f32_32x32x16_bf16(b0, qr[d0], d0 == 0 ? nm : p0, 0, 0, 0); p1 = __builtin_amdgcn_mfma_f32_32x32x16_bf16(b1, qr[d0], d0 == 0 ? nm : p1, 0, 0, 0); } } \
        if constexpr (BIAS && BANDTILE) { const int relb = (t) * KVBLK - qabs + 128; \
            _Pragma("unroll") for (int r = 0; r < 16; ++r) { int i0 = relb + (KPERM ? 16 * (r >> 3) + 8 * hi + (r & 7) : crow(r, hi)), i1 = i0 + 32; i0 = min(max(i0, 0), 256); i1 = min(max(i1, 0), 256); p0[r] += tbl[i0]; p1[r] += tbl[i1]; } } \
        _Pragma("unroll") for (int r = 0; r < 16; ++r) { p0[r] = __builtin_amdgcn_exp2f(p0[r]); p1[r] = __builtin_amdgcn_exp2f(p1[r]); } \
        float ps = 0; \
        _Pragma("unroll") for (int r = 0; r < 16; ++r) ps += p0[r]; \
        _Pragma("unroll") for (int r = 0; r < 16; ++r) ps += p1[r]; \
        if constexpr (!KPERM) { auto rr = __builtin_amdgcn_permlane32_swap(__float_as_uint(ps), __float_as_uint(ps), false, false); ps = __uint_as_float(rr[0]) + __uint_as_float(rr[1]); } \
        l_reg += ps; \
        bf16x8 pa0, pa1, pa2, pa3; PK4(p0, 0, pa0); PK4(p0, 8, pa1); PK4(p1, 0, pa2); PK4(p1, 8, pa3); \
        pv_d0(o, vb0 + (VB_), pa0, pa1, pa2, pa3); } while (0)
#define TILE3(B, t) do { if ((t) + 2 < NT) DMA2((t) + 2, (((B) + 2) % 3) * SHM_K, (((B) + 2) % 3) * SHM_V); \
        TILEC((B) * SHM_K, (B) * SHM_V, t, B, false); \
        if ((t) + 2 < NT) asm volatile("s_waitcnt vmcnt(5) lgkmcnt(0)\n\ts_barrier" ::: "memory"); else asm volatile("s_waitcnt vmcnt(0) lgkmcnt(0)\n\ts_barrier" ::: "memory"); } while (0)
#define TILEX(B, t, BANDTILE) do { if ((t) + 1 < NT) DMA2((t) + 1, ((B) ^ 1) * 8192, ((B) ^ 1) * 16384); \
        TILEC((B) * 8192, (B) * 16384, t, 0, BANDTILE); \
        asm volatile("s_waitcnt vmcnt(0)" ::: "memory"); __syncthreads(); } while (0)
#define SETNMC(cbv) do { const float nv_ = nm_ref + (cbv); _Pragma("unroll") for (int r = 0; r < 16; ++r) nm[r] = nv_; } while (0)
    static_assert(RING == 2 || NK + 2 == 5, "counted wait assumes 5 loads per thread per tile");
    if constexpr (RING == 3) {
        DMA2(0, 0, 0); DMA2(1, SHM_K, SHM_V); asm volatile("s_waitcnt vmcnt(0) lgkmcnt(0)\n\ts_barrier" ::: "memory");
        for (int j = 0; j + 2 < NT; j += 3) { TILE3(0, j); TILE3(1, j + 1); TILE3(2, j + 2); }
        static_assert((NT - 1) % 3 == 0, "tail tile must map to buffer 0");
        TILE3(0, NT - 1);
    } else {
        DMA2(0, 0, 0); asm volatile("s_waitcnt vmcnt(0)" ::: "memory"); __syncthreads();
        int t = 0;
        if constexpr (BIAS) {
            const int nL = q0 >= 191 ? (q0 - 191) / KVBLK + 1 : 0, tR = (q0 + 383 + KVBLK - 1) / KVBLK;
            const int a = (nL / 2) * 2; int be = ((tR + 1) / 2) * 2; if (be > NT) be = NT;
            SETNMC(cb_lo);
            for (; t < a; t += 2) { TILEX(0, t, false); TILEX(1, t + 1, false); }
            SETNMC(0.f);
            for (; t < be; t += 2) { TILEX(0, t, true); TILEX(1, t + 1, true); }
            SETNMC(cb_hi);
        }
        for (; t < NT; t += 2) { TILEX(0, t, false); TILEX(1, t + 1, false); }
    }
#undef TILEC
#undef TILE3
#undef TILEX
#undef SETNMC
#undef PK4
    if constexpr (KPERM) { auto rr = __builtin_amdgcn_permlane32_swap(__float_as_uint(l_reg), __float_as_uint(l_reg), false, false); l_reg = __uint_as_float(rr[0]) + __uint_as_float(rr[1]); }
    if (hi == 0) li_l[r32] = l_reg; asm volatile("s_waitcnt lgkmcnt(0)" ::: "memory");
#pragma unroll
    for (int r = 0; r < 16; ++r) { const float rl = __builtin_amdgcn_rcpf(li_l[crow(r, hi)]);
#pragma unroll
        for (int d = 0; d < 4; ++d) o[d][r] *= rl; }
#undef DMA2
}
}

__device__ __forceinline__ int t5_bucket(int rel) {
    const int n = rel < 0 ? -rel : rel; int b;
    if (n < 8) b = n; else if (n < 12) b = 8; else if (n < 16) b = 9; else if (n < 23) b = 10; else if (n < 32) b = 11; else if (n < 46) b = 12; else if (n < 64) b = 13; else if (n < 91) b = 14; else b = 15;
    return (rel > 0 ? 16 : 0) + b;
}
template <int KIND> __device__ __forceinline__ int dst_row(int n) {
    if constexpr (KIND == 1) { if (n < 3840) return n; const int d = n - 3840; return 3840 + (d < 32 ? 2 * d : 2 * (d - 32) + 1); }
    else if constexpr (KIND == 2) { const int h = n / 192, w = n - h * 192; if (w < 128) return n; const int d = w - 128; return h * 192 + 128 + (d < 32 ? 2 * d : 2 * (d - 32) + 1); }
    else if constexpr (KIND == 3) return 256 * (n >> 7) + (n & 127);
    else if constexpr (KIND == 4) return 256 * (n >> 7) + 128 + (n & 127);
    else return n;
}
template <int KIND>
__device__ __forceinline__ void transpose_item(const float* __restrict__ W, int K, int N, const float* __restrict__ g, bf16_t* __restrict__ WT, LAS float* scr, int item, int lane) {
    const int nblk = N / 32, kb = item / nblk, nb = item - kb * nblk, k0 = 64 * kb, n0 = 32 * nb;
#pragma unroll 8
    for (int i = 0; i < 32; ++i) { const int kk = 2 * i + (lane >> 5); float v = W[(size_t)(k0 + kk) * N + n0 + (lane & 31)]; if (g) v *= g[k0 + kk]; scr[kk * 33 + (lane & 31)] = v; }
    LDS_WAIT(); asm volatile("" ::: "memory");
    const int c = lane & 7;
#pragma unroll
    for (int j = 0; j < 4; ++j) { const int n = (lane >> 3) + 8 * j; const LAS float* s = scr + (8 * c) * 33 + n;
        u32x4 o; o.x = cvt_pk_bf16(s[0 * 33], s[1 * 33]); o.y = cvt_pk_bf16(s[2 * 33], s[3 * 33]); o.z = cvt_pk_bf16(s[4 * 33], s[5 * 33]); o.w = cvt_pk_bf16(s[6 * 33], s[7 * 33]);
        *(u32x4*)(WT + (size_t)dst_row<KIND>(n0 + n) * K + k0 + 8 * c) = o; }
    LDS_WAIT(); asm volatile("" ::: "memory");
}
__device__ __forceinline__ void rms_row_bf16(const float* __restrict__ xrow, const float* __restrict__ g, bf16_t* __restrict__ orow, int lane) {
    const f32x4* xr = (const f32x4*)xrow + lane; const f32x4* gr = (const f32x4*)g + lane;
    f32x4 v[8]; float s = 0.f;
#pragma unroll
    for (int j = 0; j < 8; ++j) { v[j] = xr[64 * j]; s += (v[j].x * v[j].x + v[j].y * v[j].y) + (v[j].z * v[j].z + v[j].w * v[j].w); }
    const float rstd = rsqrtf(wave_sum(s) * (1.f / DM) + EPS);
    u32x2* o8 = (u32x2*)orow + lane;
#pragma unroll
    for (int j = 0; j < 8; ++j) { const f32x4 gg = gr[64 * j]; u32x2 w; w.x = cvt_pk_bf16(v[j].x * rstd * gg.x, v[j].y * rstd * gg.y); w.y = cvt_pk_bf16(v[j].z * rstd * gg.z, v[j].w * rstd * gg.w); o8[64 * j] = w; }
}
__device__ __forceinline__ void rms_row_f32(float* xrow, const float* __restrict__ g, int lane) {
    f32x4* xr = (f32x4*)xrow + lane; const f32x4* gr = (const f32x4*)g + lane;
    f32x4 v[8]; float s = 0.f;
#pragma unroll
    for (int j = 0; j < 8; ++j) { v[j] = xr[64 * j]; s += (v[j].x * v[j].x + v[j].y * v[j].y) + (v[j].z * v[j].z + v[j].w * v[j].w); }
    const float rstd = rsqrtf(wave_sum(s) * (1.f / DM) + EPS);
#pragma unroll
    for (int j = 0; j < 8; ++j) xr[64 * j] = v[j] * rstd * gr[64 * j];
}

#define XB_TMO      128
#define XB_XCNT(j)  (256  + 64 * (j))
#define XB_XSUB(j)  (1280 + 64 * (j))
#define XB_XGEN(j)  (2304 + 64 * (j))
#define XB_TOP      3328
#define XB_TOPGEN   3392
#define XCD_BAR_WORDS 3456
#define XB_SPIN_CAP (1u << 20)

__device__ __forceinline__ unsigned xb_ld(unsigned* p)              { return __hip_atomic_load(p, __ATOMIC_RELAXED, __HIP_MEMORY_SCOPE_AGENT); }
__device__ __forceinline__ unsigned xb_add(unsigned* p, unsigned v) { return __hip_atomic_fetch_add(p, v, __ATOMIC_RELAXED, __HIP_MEMORY_SCOPE_AGENT); }
__device__ __forceinline__ unsigned xb_xcc_id() { return (unsigned)__builtin_amdgcn_s_getreg((3 << 11) | 20) & 0xFu; }
#define XB_SPIN(cond, bar) do { unsigned _sp = 0; while (cond) { __builtin_amdgcn_s_sleep(1); \
    if ((++_sp & 255u) == 0u) { if (xb_ld(&(bar)[XB_TMO])) break; if (_sp > XB_SPIN_CAP) { atomicAdd(&(bar)[XB_TMO], 1u); break; } } } } while (0)

struct XcdBarrier {
    unsigned* bar; unsigned x;
    volatile LAS unsigned* st;
};

__device__ __forceinline__ XcdBarrier xcd_barrier_post(unsigned* bar, volatile LAS unsigned* st) {
    XcdBarrier b; b.bar = bar; b.x = xb_xcc_id(); b.st = st;
    if (threadIdx.x == 0) (void)xb_add(&bar[XB_XCNT(b.x)], 1u);
    return b;
}
__device__ __forceinline__ void xcd_barrier_complete(unsigned* bar, unsigned x, unsigned& nloc, unsigned& nx) {
    const unsigned G = gridDim.x * gridDim.y * gridDim.z;
    unsigned sum, cnt, mine, sp = 0u;
    for (;;) {
        sum = 0u; cnt = 0u; mine = 0u;
#pragma unroll
        for (unsigned j = 0; j < 16; ++j) { const unsigned c = xb_ld(&bar[XB_XCNT(j)]); sum += c; cnt += (c > 0u) ? 1u : 0u; mine = (j == x) ? c : mine; }
        if (sum == G) break;
        __builtin_amdgcn_s_sleep(1);
        if ((++sp & 255u) == 0u) { if (xb_ld(&bar[XB_TMO])) break; if (sp > XB_SPIN_CAP) { atomicAdd(&bar[XB_TMO], 1u); break; } }
    }
    nloc = mine > 0u ? mine : 1u; nx = cnt > 0u ? cnt : 1u;
}

__device__ __forceinline__ void xcd_barrier(const XcdBarrier& b) {
    asm volatile("s_waitcnt vmcnt(0)" ::: "memory");
    __syncthreads();
    if (threadIdx.x == 0) {
        unsigned* bar = b.bar;
        __builtin_amdgcn_s_waitcnt(0);
        unsigned nloc = b.st[0], nx = b.st[1];
        if (nloc == 0u) { xcd_barrier_complete(bar, b.x, nloc, nx); b.st[0] = nloc; b.st[1] = nx; }
        const unsigned old = xb_add(&bar[XB_XSUB(b.x)], 1u);
        const unsigned gen = old / nloc;
        if (old + 1u == (gen + 1u) * nloc) {
            __builtin_amdgcn_fence(__ATOMIC_RELEASE, "agent");
            asm volatile("s_waitcnt vmcnt(0)" ::: "memory");
            const unsigned og = xb_add(&bar[XB_TOP], 1u);
            const unsigned tg = og / nx;
            if (og + 1u == (tg + 1u) * nx) xb_add(&bar[XB_TOPGEN], 1u);
            else XB_SPIN(xb_ld(&bar[XB_TOPGEN]) == tg, bar);
            __builtin_amdgcn_fence(__ATOMIC_ACQUIRE, "agent");
            xb_add(&bar[XB_XGEN(b.x)], 1u);
            asm volatile("s_waitcnt vmcnt(0)" ::: "memory");
        } else {
            XB_SPIN(xb_ld(&bar[XB_XGEN(b.x)]) == gen, bar);
            __builtin_amdgcn_fence(__ATOMIC_ACQUIRE, "agent");
            asm volatile("s_waitcnt vmcnt(0)" ::: "memory");
        }
    }
    __syncthreads();
}
constexpr int LDS_BYTES = 147456;
struct Args { const float* in[19]; float* out; unsigned char* ws; int ph_lo, ph_hi; };

__global__ void __launch_bounds__(512, 2) fwd_mega(Args args) {
    extern __shared__ __attribute__((aligned(16))) unsigned char lds_raw[];
    LAS unsigned char* lds = (LAS unsigned char*)lds_raw;
    cg::grid_group grid = cg::this_grid();
    const int tid = threadIdx.x, lane = tid & 63, wave = __builtin_amdgcn_readfirstlane(tid >> 6);
    const int G = gridDim.x, bx = blockIdx.x;
    { volatile LAS unsigned* st0_ = (volatile LAS unsigned*)(lds + LDS_BYTES - 16); if (tid < 2) st0_[tid] = 0u; }
    __syncthreads();
    const XcdBarrier xbar = xcd_barrier_post((unsigned*)(args.ws + WS_BAR), (volatile LAS unsigned*)(lds + LDS_BYTES - 16));
    unsigned char* ws = args.ws;
    const float* x = args.in[0];
    bf16_t* Wt_uq = (bf16_t*)(ws + WS_WUQ); bf16_t* Wt_ukv = (bf16_t*)(ws + WS_WUKV); bf16_t* Wt_in = (bf16_t*)(ws + WS_WIN); bf16_t* Wt_out = (bf16_t*)(ws + WS_WOUT);
    bf16_t* Wt_gu = (bf16_t*)(ws + WS_WGU); bf16_t* Wt_dn = (bf16_t*)(ws + WS_WDN);
    bf16_t* HB = (bf16_t*)(ws + WS_HB); float* X1 = (float*)(ws + WS_X1); float* O1 = (float*)(ws + WS_O1);
    bf16_t* CQ = (bf16_t*)(ws + WS_CQ); bf16_t* CKV = (bf16_t*)(ws + WS_CKV); bf16_t* VB = (bf16_t*)(ws + WS_VB);
    bf16_t* QA = (bf16_t*)(ws + WS_QA); bf16_t* KA = (bf16_t*)(ws + WS_KA); bf16_t* VA = (bf16_t*)(ws + WS_VA); bf16_t* QB = (bf16_t*)(ws + WS_QB); bf16_t* KB = (bf16_t*)(ws + WS_KB);
    bf16_t* ACT = (bf16_t*)(ws + WS_ACT);
    float* LAM = (float*)(ws + WS_CTL); float* TBL = (float*)(ws + WS_TBL); float* SSQQ = (float*)(ws + WS_SSQQ); float* SSQKV = (float*)(ws + WS_SSQKV);
    float* COS = (float*)(ws + WS_COS); float* SIN = (float*)(ws + WS_SIN);
    const int lo = args.ph_lo, hi_ph = args.ph_hi;
#ifndef PH_MASK
#define PH_MASK 0x1ff
#endif
#define IN(k) (((PH_MASK >> (k)) & 1) && lo <= (k) && (k) < hi_ph)
#define GRID_BAR() xcd_barrier(xbar)
#define SEAM(k) do { if (IN(k) && IN((k) + 1)) { if ((k) == 0) grid.sync(); else GRID_BAR(); } } while (0)

    if (IN(0)) {
        LAS float* scr = (LAS float*)(lds + wave * 16384);
        const int gw = bx * 8 + wave, NGW = G * 8;
        constexpr int I_IN = (DM / 64) * (NIN / 32), I_UQ = (QLR / 64) * (NQB / 32), I_UKV = (KVLR / 64) * (NKV / 32), I_OUT = (DM / 64) * (DM / 32), I_G = (DM / 64) * (DFF / 32), I_DN = (DFF / 64) * (DM / 32);
        constexpr int NITEMS = I_IN + I_UQ + I_UKV + I_OUT + 2 * I_G + I_DN;
        for (int it = gw; it < NITEMS; it += NGW) {
            int r = it;
            if (r < I_IN) { transpose_item<1>(args.in[2], DM, NIN, nullptr, Wt_in, scr, r, lane); continue; } r -= I_IN;
            if (r < I_UQ) { transpose_item<2>(args.in[4], QLR, NQB, args.in[3], Wt_uq, scr, r, lane); continue; } r -= I_UQ;
            if (r < I_UKV) { transpose_item<0>(args.in[6], KVLR, NKV, args.in[5], Wt_ukv, scr, r, lane); continue; } r -= I_UKV;
            if (r < I_OUT) { transpose_item<0>(args.in[13], DM, DM, nullptr, Wt_out, scr, r, lane); continue; } r -= I_OUT;
            if (r < I_G) { transpose_item<3>(args.in[15], DM, DFF, nullptr, Wt_gu, scr, r, lane); continue; } r -= I_G;
            if (r < I_G) { transpose_item<4>(args.in[16], DM, DFF, nullptr, Wt_gu, scr, r, lane); continue; } r -= I_G;
            transpose_item<0>(args.in[17], DFF, DM, nullptr, Wt_dn, scr, r, lane);
        }
        for (int m = gw; m < S; m += NGW) rms_row_bf16(x + (size_t)m * DM, args.in[1], HB + (size_t)m * DM, lane);
        const int gt = bx * 512 + tid, NGT = G * 512;
        for (int i = gt; i < (NINP - NIN) * DM / 8; i += NGT) ((u32x4*)(Wt_in + (size_t)NIN * DM))[i] = (u32x4){0u, 0u, 0u, 0u};
        for (int i = gt; i < S; i += NGT) { SSQQ[i] = 0.f; SSQKV[i] = 0.f; }
        for (int i = gt; i < S * 32; i += NGT) { const int pos = i >> 5, f = i & 31; const float inv = powf(10000.f, -(float)f / 32.f); const float ang = (float)pos * inv; COS[i] = cosf(ang); SIN[i] = sinf(ang); }
        if (gt < 32) ((float*)(ws + WS_KMXA))[gt] = 0.f; else if (gt < 64) ((float*)(ws + WS_KMXB))[gt - 32] = 0.f; else if (gt < 66) ((float*)(ws + WS_KMXR))[gt - 64] = 0.f;
        else if (gt < 74) { const int h = gt - 66; float mx = -1e30f; for (int bk = 0; bk < 32; ++bk) mx = fmaxf(mx, args.in[12][bk * 8 + h]); ((float*)(ws + WS_TBLMAX))[h] = mx * LOG2E; }
        for (int i = gt; i < 8 * 257; i += NGT) { const int h = i / 257, idx = i - h * 257; TBL[i] = args.in[12][t5_bucket(idx - 128) * 8 + h] * LOG2E; }
        if (bx == 0 && wave == 0) { const float s1 = wave_sum(args.in[7][lane] * args.in[8][lane]), s2 = wave_sum(args.in[9][lane] * args.in[10][lane]);
            if (lane == 0) LAM[0] = expf(s1) - expf(s2) + 0.2f; }
        __syncthreads();
    }
    SEAM(0);
    if (IN(1)) {
        pg8::Gemm g{HB, Wt_in, S, NINP, DM}; pg8::StaticOrder So; So.init(S, NINP, G, bx);
        EpiIn E{ws};
        pg8::gemm_phase<EpiIn, pg8::StaticOrder, true, true>(lds, g, So, E);
    }
    SEAM(1);
    if (IN(2)) {
        { pg8::Gemm g{CQ, Wt_uq, S, NQB, QLR}; pg8::StaticOrder So; So.init(S, NQB, G, bx); EpiQB E{QB, SSQQ, COS, SIN};
          pg8::gemm_phase<EpiQB, pg8::StaticOrder, true, true>(lds, g, So, E); }
        { pg8::Gemm g{CKV, Wt_ukv, S, NKV, KVLR}; pg8::StaticOrder So; So.init(S, NKV, G, bx); EpiKV E{KB, VB, SSQKV, (unsigned*)(ws + WS_KMXB)};
          pg8::gemm_phase<EpiKV, pg8::StaticOrder, true, true>(lds, g, So, E); }
    }
    SEAM(2);
    if (IN(3)) {
        const int r32 = lane & 31, hi = lane >> 5;
        const float lam = __uint_as_float(__builtin_amdgcn_readfirstlane(__float_as_uint(LAM[0])));
        LAS float* tbl_l = (LAS float*)(lds + att::OFF_TBL);
        const float* KMXA = (const float*)(ws + WS_KMXA); const float* KMXB = (const float*)(ws + WS_KMXB); const float* KMXR = (const float*)(ws + WS_KMXR); const float* TBLMAX = (const float*)(ws + WS_TBLMAX);
        float* OXb = O1 + (size_t)bx * (2 * 256 * 128);
#ifndef REPA
#define REPA 1
#endif
#ifndef REPB
#define REPB 1
#endif
        for (int rep = 0; rep < REPA; ++rep)
        for (int it = 0; ; ++it) {
            const int u = bx + (it >> 1) * G, mp = it & 1; if (u >= 512) break;
            const int h = u & 7, q0 = (u >> 3) * 256;
            for (int i = tid; i < 257; i += 512) tbl_l[i] = TBL[h * 257 + i];
            const float cb_lo = __uint_as_float(__builtin_amdgcn_readfirstlane(__float_as_uint(TBL[h * 257]))), cb_hi = __uint_as_float(__builtin_amdgcn_readfirstlane(__float_as_uint(TBL[h * 257 + 256])));
            f32x16 o[4];
            const float kmx = sqrtf(__uint_as_float(__builtin_amdgcn_readfirstlane(__float_as_uint(KMXA[(h * 2 + mp) * 2] + KMXA[(h * 2 + mp) * 2 + 1])))), bmx = __uint_as_float(__builtin_amdgcn_readfirstlane(__float_as_uint(TBLMAX[h])));
            att::attn_f<64, true, 1024, 1024, 1024>(QA + (size_t)q0 * 1024 + h * 128 + mp * 64, KA + h * 128 + mp * 64, VA + h * 128, lds, q0, cb_lo, cb_hi, kmx, bmx, o);
            { float* OX = OXb + mp * (256 * 128) + (wave * 32) * 128 + r32;
#pragma unroll
                for (int r = 0; r < 16; ++r)
#pragma unroll
                    for (int d = 0; d < 4; ++d) OX[att::crow(r, hi) * 128 + d * 32] = o[d][r]; }
            if (mp == 1) {
                __threadfence(); __syncthreads();
                const f32x2 gs = *(const f32x2*)(args.in[11] + 2 * lane);
                for (int rr = wave; rr < 256; rr += 32) {
                    float v0[4], v1[4], ss[4];
#pragma unroll
                    for (int q = 0; q < 4; ++q) { const int row = rr + 8 * q;
                        const f32x2 a = *(const f32x2*)(OXb + row * 128 + 2 * lane), b = *(const f32x2*)(OXb + 256 * 128 + row * 128 + 2 * lane);
                        v0[q] = a.x - lam * b.x; v1[q] = a.y - lam * b.y; ss[q] = v0[q] * v0[q] + v1[q] * v1[q]; }
#pragma unroll
                    for (int o_ = 1; o_ < 64; o_ <<= 1)
#pragma unroll
                        for (int q = 0; q < 4; ++q) ss[q] += __shfl_xor(ss[q], o_);
#pragma unroll
                    for (int q = 0; q < 4; ++q) { const float rstd = rsqrtf(ss[q] * (1.f / 128.f) + EPS) * 0.8f;
                        *(unsigned*)(HB + (size_t)(q0 + rr + 8 * q) * DM + h * 128 + 2 * lane) = cvt_pk_bf16(v0[q] * rstd * gs.x, v1[q] * rstd * gs.y); }
                }
                __syncthreads();
            }
        }
        for (int rep = 0; rep < REPB; ++rep)
        for (int u = bx; u < 512; u += G) {
            const int h = u & 7, q0 = (u >> 3) * 256;
            f32x16 o[4];
            const float kmx = sqrtf(__uint_as_float(__builtin_amdgcn_readfirstlane(__float_as_uint((KMXB[h * 4] + KMXB[h * 4 + 1]) + (KMXB[h * 4 + 2] + KMXB[h * 4 + 3]) + (KMXR[0] + KMXR[1])))));
            att::attn_f<192, false, NQB, NQB, 1024>(QB + (size_t)q0 * NQB + h * 192, KB + h * 192, VB + h * 128, lds, q0, 0.f, 0.f, kmx, 0.f, o);
            bf16_t* mix = HB + (size_t)(q0 + wave * 32) * DM + 1024 + h * 128 + r32;
#pragma unroll
            for (int r = 0; r < 16; ++r)
#pragma unroll
                for (int d = 0; d < 4; ++d) mix[(size_t)att::crow(r, hi) * DM + d * 32] = (bf16_t)(cvt_pk_bf16(o[d][r], 0.f) & 0xffffu);
        }
        __syncthreads();
    }
    SEAM(3);
    if (IN(4)) {
        pg8::Gemm g{HB, Wt_out, S, DM, DM}; pg8::StaticOrder So; So.init(S, DM, G, bx); EpiRes E{x, X1};
        pg8::gemm_phase<EpiRes, pg8::StaticOrder, true, true>(lds, g, So, E);
    }
    SEAM(4);
    if (IN(5)) {
        const int gw = bx * 8 + wave, NGW = G * 8;
        for (int m = gw; m < S; m += NGW) rms_row_bf16(X1 + (size_t)m * DM, args.in[14], HB + (size_t)m * DM, lane);
    }
    SEAM(5);
    if (IN(6)) {
        pg8::Gemm g{HB, Wt_gu, S, NGU, DM}; pg8::StaticOrder So; So.init(S, NGU, G, bx); EpiGU E{ACT};
#ifndef REP6
#define REP6 1
#endif
        for (int rep = 0; rep < REP6; ++rep)
        pg8::gemm_phase<EpiGU, pg8::StaticOrder, true, true>(lds, g, So, E);
    }
    SEAM(6);
    if (IN(7)) {
        pg8::Gemm g{ACT, Wt_dn, S, DM, DFF}; pg8::StaticOrder So; So.init(S, DM, G, bx); EpiRes E{X1, args.out};
        pg8::gemm_phase<EpiRes, pg8::StaticOrder, true, true>(lds, g, So, E);
    }
    SEAM(7);
    if (IN(8)) {
        const int gw = bx * 8 + wave, NGW = G * 8;
        for (int m = gw; m < S; m += NGW) rms_row_f32(args.out + (size_t)m * DM, args.in[18], lane);
    }
#undef IN
#undef SEAM
}

extern "C" void kernel_launch(void* const* d_in, const int* in_sizes, int n_in, void* d_out, int out_size, void* d_ws, size_t ws_size, hipStream_t stream) {
    static int grid = 0;
    if (grid == 0) {
        if (n_in != 19 || in_sizes[0] != S * DM || out_size != S * DM || ws_size < WS_END) {
            fprintf(stderr, "kernel_launch: shape/workspace mismatch: n_in %d in0 %d out %d ws %zu (need %zu)\n", n_in, n_in > 0 ? in_sizes[0] : -1, out_size, ws_size, (size_t)WS_END); grid = -1; return; }
        int dev = 0, cus = 0, per_cu = 0;
        (void)hipGetDevice(&dev); (void)hipDeviceGetAttribute(&cus, hipDeviceAttributeMultiprocessorCount, dev);
        if (hipFuncSetAttribute((const void*)fwd_mega, hipFuncAttributeMaxDynamicSharedMemorySize, LDS_BYTES) != hipSuccess) { fprintf(stderr, "kernel_launch: hipFuncSetAttribute failed\n"); grid = -1; return; }
        if (hipOccupancyMaxActiveBlocksPerMultiprocessor(&per_cu, (const void*)fwd_mega, 512, LDS_BYTES) != hipSuccess || per_cu < 1) { fprintf(stderr, "kernel_launch: occupancy query says %d\n", per_cu); per_cu = 1; }
        (void)hipGetLastError();
        grid = cus < 256 ? cus : 256;
    }
    if (grid < 0) return;
    Args a{};
    for (int i = 0; i < 19; ++i) a.in[i] = (const float*)d_in[i];
    a.out = (float*)d_out; a.ws = (unsigned char*)d_ws;
#if MK_N_LAUNCHES == 1
    a.ph_lo = 0; a.ph_hi = NPHASE;
    void* kargs[] = {&a};
    (void)hipMemsetAsync((char*)d_ws + WS_BAR, 0, 16384, stream);
    hipError_t e = hipLaunchCooperativeKernel((const void*)fwd_mega, dim3(grid), dim3(512), kargs, LDS_BYTES, stream);
    if (e != hipSuccess) fprintf(stderr, "kernel_launch: cooperative launch failed: %s (grid %d)\n", hipGetErrorString(e), grid);
#else
    for (int p = 0; p < NPHASE; ++p) { a.ph_lo = p; a.ph_hi = p + 1; hipLaunchKernelGGL(fwd_mega, dim3(grid), dim3(512), LDS_BYTES, stream, a); }
#endif
}
```

```cpp
#define NO_SBAR 1
#include <hip/hip_runtime.h>
#include <hip/hip_cooperative_groups.h>
#include <cstdio>
#include <cstdint>
namespace cg = cooperative_groups;

#ifndef MK_N_LAUNCHES
#define MK_N_LAUNCHES 1
#endif

#define LAS __attribute__((address_space(3)))
typedef unsigned short bf16_t;
typedef short bf16x8 __attribute__((ext_vector_type(8)));
typedef short s16x4 __attribute__((ext_vector_type(4)));
typedef float f32x4 __attribute__((ext_vector_type(4)));
typedef float f32x2 __attribute__((ext_vector_type(2)));
typedef float f32x16 __attribute__((ext_vector_type(16)));
typedef unsigned u32x4 __attribute__((ext_vector_type(4)));
typedef unsigned u32x2 __attribute__((ext_vector_type(2)));

constexpr int S = 16384, DM = 2048, NIN = 3904, NINP = 4096, DFF = 5632, NGU = 2 * DFF;
constexpr int QLR = 512, KVLR = 256, NQB = 1536, NKV = 2048;
constexpr float EPS = 1e-6f, LOG2E = 1.4426950408889634f;
constexpr int NPHASE = 9;

constexpr size_t MiB = 1u << 20;
constexpr size_t WS_CTL = 0;
constexpr size_t WS_TBL = 4096, WS_SSQQ = 65536, WS_SSQKV = 131072, WS_KMXA = 256, WS_KMXB = 384, WS_TBLMAX = 512, WS_KMXR = 640;
constexpr size_t WS_BAR = 262144;
constexpr size_t WS_COS = 1 * MiB, WS_SIN = 3 * MiB;
constexpr size_t WS_WUQ = 5 * MiB, WS_WUKV = 7 * MiB, WS_WIN = 8 * MiB, WS_WOUT = 24 * MiB, WS_WGU = 32 * MiB, WS_WDN = 76 * MiB;
constexpr size_t WS_HB = 98 * MiB;
constexpr size_t WS_X1 = 162 * MiB;
constexpr size_t WS_O1 = WS_X1, WS_CQ = WS_X1 + 64 * MiB, WS_CKV = WS_X1 + 80 * MiB, WS_VB = WS_X1 + 88 * MiB;
constexpr size_t WS_R = 290 * MiB;
constexpr size_t WS_QA = WS_R, WS_KA = WS_R + 32 * MiB, WS_VA = WS_R + 64 * MiB, WS_QB = WS_R + 96 * MiB, WS_KB = WS_R + 144 * MiB;
constexpr size_t WS_ACT = WS_R;
constexpr size_t WS_END = WS_R + 192 * MiB;

__device__ __forceinline__ unsigned cvt_pk_bf16(float lo, float hi) { unsigned r; asm volatile("v_cvt_pk_bf16_f32 %0, %1, %2" : "=v"(r) : "v"(lo), "v"(hi)); return r; }
__device__ __forceinline__ float wave_sum(float v) {
#pragma unroll
    for (int o = 1; o < 64; o <<= 1) v += __shfl_xor(v, o);
    return v;
}
#define LDS_WAIT() asm volatile("s_waitcnt lgkmcnt(0)" ::: "memory")

namespace pg8 {
constexpr int BM = 256, BK = 64, HALF = 128, HTB = HALF * BK * 2, STAGE_BYTES = 8 * HTB, NXCD = 8, WGM = 8;
__host__ __device__ __forceinline__ int lds_byte(int r, int c) { const int st = (r >> 4) * 2 + (c >> 5), rr = r & 15, cc = c & 31, ob = rr * 64 + cc * 2; return st * 1024 + (ob ^ (((ob >> 9) & 1) << 5)); }
__host__ __device__ __forceinline__ void stage_rc(int b, int& R, int& C) { const int st = b / 1024, sb = b % 1024, swz = sb ^ (((sb >> 9) & 1) << 5); R = (st >> 1) * 16 + swz / 64; C = (st & 1) * 32 + (swz % 64) / 2; }
__host__ __device__ __forceinline__ int perm32(int rho) { const int n = rho >> 4, i = rho & 15; return 8 * (i >> 2) + 4 * n + (i & 3); }
struct Unit { int pm, pn; };
struct Gemm { const bf16_t* A; const bf16_t* Bt; int M, N, K; };
struct StaticOrder {
    int nM, nN, nwg, G, c;
    __host__ __device__ void init(int M, int N, int G_, int c_) { nM = M / BM; nN = N / BM; nwg = nM * nN; G = G_; c = c_; }
    __host__ __device__ bool next(int i, Unit& u) const {
        const long L = (long)i * G + c; if (L >= nwg) return false;
        int wgid = (int)L; { const int q = nwg / NXCD, r = nwg % NXCD, xcd = wgid % NXCD, off = wgid / NXCD; wgid = (xcd < r ? xcd * (q + 1) : r * (q + 1) + (xcd - r) * q) + off; }
        const int nig = WGM * nN, gid = wgid / nig, fm = gid * WGM, gsz = (nM - fm) < WGM ? (nM - fm) : WGM;
        u.pm = fm + ((wgid % nig) % gsz); u.pn = (wgid % nig) / gsz; return true;
    }
    __device__ __forceinline__ void a_ready(const Unit&) const {}
    __device__ __forceinline__ void done(const Unit&) const {}
};
template <class Epi, class Sched, bool ALIGN_EPI = false, bool SP2 = false>
__device__ __forceinline__ void gemm_phase(LAS unsigned char* lds, const Gemm g, const Sched& Sd, const Epi& E) {
    int tid_ = threadIdx.x; asm volatile("" : "+v"(tid_));
    const int tid = tid_, wid = __builtin_amdgcn_readfirstlane(tid >> 6), lane = tid & 63, wr = wid >> 2, wc = wid & 3, fr = lane & 15, fq = lane >> 4;
    const int K = g.K, nt = K / BK;
    unsigned voffA[2], voffB[2];
#pragma unroll
    for (int i = 0; i < 2; ++i) { int R, C; stage_rc(tid * 16 + i * 8192, R, C); const int Rb = Epi::PERM ? ((R & ~31) + perm32(R & 31)) : R;
        voffA[i] = (unsigned)(R * K + C) * 2u; voffB[i] = (unsigned)(Rb * K + C) * 2u; }
    const size_t kstep = (size_t)(BK * 2);
    const size_t hstep = (size_t)HALF * K * 2;
    const size_t tstep = 2 * hstep;
    const unsigned ldsw = (unsigned)wid * 1024u;
    const int aoff = lds_byte(wr * 64 + fr, fq * 8), boff = lds_byte(wc * 32 + fr, fq * 8);
#define PG8_SA(b, h) (((b) * 2 + (h)) * HTB)
#define PG8_SB(b, h) ((4 + (b) * 2 + (h)) * HTB)
#define PG8_STAGE(bufoff, gbase, voff) do { _Pragma("unroll") for (int _i = 0; _i < 2; ++_i) \
        __builtin_amdgcn_global_load_lds((const unsigned*)((const char*)(gbase) + (voff)[_i]), (LAS unsigned*)(lds + (bufoff) + ldsw + _i * 8192), 16, 0, 0); } while (0)
#define PG8_LDA(dst, b, h) do { _Pragma("unroll") for (int m = 0; m < 4; ++m) _Pragma("unroll") for (int k = 0; k < 2; ++k) dst[m][k] = *(const LAS bf16x8*)(lds + PG8_SA(b, h) + aoff + m * 2048 + k * 1024); } while (0)
#define PG8_LDB(dst, b, h) do { _Pragma("unroll") for (int n = 0; n < 2; ++n) _Pragma("unroll") for (int k = 0; k < 2; ++k) dst[n][k] = *(const LAS bf16x8*)(lds + PG8_SB(b, h) + boff + n * 2048 + k * 1024); } while (0)
#define PG8_MMA(ai, bj, At, Bt) do { __builtin_amdgcn_s_setprio(1); _Pragma("unroll") for (int m = 0; m < 4; ++m) _Pragma("unroll") for (int n = 0; n < 2; ++n) _Pragma("unroll") for (int k = 0; k < 2; ++k) \
        acc[ai][bj][m][n] = __builtin_amdgcn_mfma_f32_16x16x32_bf16(Bt[n][k], At[m][k], acc[ai][bj][m][n], 0, 0, 0); __builtin_amdgcn_s_setprio(0); } while (0)
#define PG8_WAIT_V(n) asm volatile("s_waitcnt vmcnt(" #n ")" ::: "memory")
#define PG8_WAIT_L(n) asm volatile("s_waitcnt lgkmcnt(" #n ")" ::: "memory")
#define PG8_BAR __builtin_amdgcn_s_barrier()
#define PG8_SCHED __builtin_amdgcn_sched_barrier(0)
    Unit cur, nxt; int ui = 0;
    if (!Sd.next(0, cur)) return;
    f32x4 acc[2][2][4][2];
#pragma unroll
    for (int a = 0; a < 2; ++a)
#pragma unroll
        for (int b = 0; b < 2; ++b)
#pragma unroll
            for (int m = 0; m < 4; ++m)
#pragma unroll
                for (int n = 0; n < 2; ++n) acc[a][b][m][n] = (f32x4){0.f, 0.f, 0.f, 0.f};
    bf16x8 At[4][2], B0[2][2], B1[2][2];
    const char* cA = (const char*)g.A + (size_t)cur.pm * tstep; const char* cB = (const char*)g.Bt + (size_t)cur.pn * tstep;
    Sd.a_ready(cur);
    if constexpr (SP2) {
        PG8_STAGE(PG8_SB(0, 0), cB, voffB); PG8_STAGE(PG8_SB(0, 1), cB + hstep, voffB); PG8_STAGE(PG8_SA(0, 0), cA, voffA); PG8_STAGE(PG8_SA(0, 1), cA + hstep, voffA);
        if (wr == 1) PG8_BAR;
        PG8_WAIT_V(2); PG8_BAR;
        PG8_STAGE(PG8_SB(1, 0), cB + kstep, voffB); PG8_STAGE(PG8_SA(1, 0), cA + kstep, voffA); PG8_STAGE(PG8_SB(1, 1), cB + hstep + kstep, voffB);
        PG8_WAIT_V(6); PG8_BAR;
    } else {
        PG8_STAGE(PG8_SB(0, 0), cB, voffB); PG8_STAGE(PG8_SA(0, 0), cA, voffA); PG8_STAGE(PG8_SB(0, 1), cB + hstep, voffB); PG8_STAGE(PG8_SA(0, 1), cA + hstep, voffA);
        if (wr == 1) PG8_BAR;
        PG8_WAIT_V(4); PG8_BAR;
        PG8_STAGE(PG8_SB(1, 0), cB + kstep, voffB); PG8_STAGE(PG8_SA(1, 0), cA + kstep, voffA); PG8_STAGE(PG8_SB(1, 1), cB + hstep + kstep, voffB);
        PG8_WAIT_V(6); PG8_BAR;
    }
    for (;;) {
        const bool has_next = Sd.next(ui + 1, nxt);
        const char* nA = has_next ? (const char*)g.A + (size_t)nxt.pm * tstep : cA; const char* nB = has_next ? (const char*)g.Bt + (size_t)nxt.pn * tstep : cB;
        for (int t = 0; t < nt; t += 2) {
            const bool last = (t == nt - 2);
            const char* a1 = cA + (size_t)(t + 1) * kstep;
            const char* a2 = last ? nA : cA + (size_t)(t + 2) * kstep; const char* b2 = last ? nB : cB + (size_t)(t + 2) * kstep;
            const char* a3 = a2 + kstep; const char* b3 = b2 + kstep;
            if (last && has_next) Sd.a_ready(nxt);
            if constexpr (SP2) {
            PG8_LDB(B0, 0, 0); PG8_LDB(B1, 0, 1); PG8_SCHED; PG8_LDA(At, 0, 0); PG8_STAGE(PG8_SA(1, 1), a1 + hstep, voffA);
            PG8_WAIT_V(8); PG8_WAIT_L(0); PG8_BAR; PG8_MMA(0, 0, At, B0); PG8_MMA(0, 1, At, B1); PG8_BAR; PG8_SCHED;
            PG8_LDA(At, 0, 1); PG8_STAGE(PG8_SB(0, 0), b2, voffB); PG8_STAGE(PG8_SB(0, 1), b2 + hstep, voffB); PG8_STAGE(PG8_SA(0, 0), a2, voffA);
            PG8_WAIT_V(8); PG8_WAIT_L(0); PG8_BAR; PG8_MMA(1, 0, At, B0); PG8_MMA(1, 1, At, B1); PG8_BAR; PG8_SCHED;
            PG8_LDB(B0, 1, 0); PG8_LDB(B1, 1, 1); PG8_SCHED; PG8_LDA(At, 1, 0); PG8_STAGE(PG8_SA(0, 1), a2 + hstep, voffA);
            PG8_WAIT_V(8); PG8_WAIT_L(0); PG8_BAR; PG8_MMA(0, 0, At, B0); PG8_MMA(0, 1, At, B1); PG8_BAR; PG8_SCHED;
            PG8_LDA(At, 1, 1); PG8_STAGE(PG8_SB(1, 0), b3, voffB); PG8_STAGE(PG8_SB(1, 1), b3 + hstep, voffB); PG8_STAGE(PG8_SA(1, 0), a3, voffA);
            PG8_WAIT_V(8); PG8_WAIT_L(0); PG8_BAR; PG8_MMA(1, 0, At, B0); PG8_MMA(1, 1, At, B1); PG8_BAR; PG8_SCHED;
            } else {
            PG8_LDB(B0, 0, 0); PG8_SCHED; PG8_LDA(At, 0, 0); PG8_STAGE(PG8_SA(1, 1), a1 + hstep, voffA);
            PG8_WAIT_L(8); PG8_BAR; PG8_WAIT_L(0); PG8_MMA(0, 0, At, B0); PG8_BAR; PG8_SCHED;
            PG8_LDB(B1, 0, 1); PG8_STAGE(PG8_SB(0, 0), b2, voffB);
            PG8_BAR; PG8_WAIT_L(0); PG8_MMA(0, 1, At, B1); PG8_BAR;
            PG8_LDA(At, 0, 1); PG8_STAGE(PG8_SA(0, 0), a2, voffA);
            PG8_BAR; PG8_WAIT_L(0); PG8_MMA(1, 0, At, B0); PG8_BAR; PG8_SCHED;
            PG8_STAGE(PG8_SB(0, 1), b2 + hstep, voffB);
            PG8_WAIT_V(6); PG8_BAR; PG8_MMA(1, 1, At, B1); PG8_BAR;
            PG8_LDB(B0, 1, 0); PG8_SCHED; PG8_LDA(At, 1, 0); PG8_STAGE(PG8_SA(0, 1), a2 + hstep, voffA);
            PG8_WAIT_L(8); PG8_BAR; PG8_WAIT_L(0); PG8_MMA(0, 0, At, B0); PG8_BAR; PG8_SCHED;
            PG8_LDB(B1, 1, 1); PG8_STAGE(PG8_SB(1, 0), b3, voffB);
            PG8_BAR; PG8_WAIT_L(0); PG8_MMA(0, 1, At, B1); PG8_BAR;
            PG8_LDA(At, 1, 1); PG8_STAGE(PG8_SA(1, 0), a3, voffA);
            PG8_BAR; PG8_WAIT_L(0); PG8_MMA(1, 0, At, B0); PG8_BAR; PG8_SCHED;
            PG8_STAGE(PG8_SB(1, 1), b3 + hstep, voffB);
            PG8_WAIT_V(6); PG8_BAR; PG8_MMA(1, 1, At, B1); PG8_BAR;
            }
        }
        if constexpr (ALIGN_EPI) { if (wr == 0) PG8_BAR; }
        E(acc, cur, wr, wc, fr, fq); Sd.done(cur);
        if (!has_next) break;
#pragma unroll
        for (int a = 0; a < 2; ++a)
#pragma unroll
            for (int b = 0; b < 2; ++b)
#pragma unroll
                for (int m = 0; m < 4; ++m)
#pragma unroll
                    for (int n = 0; n < 2; ++n) acc[a][b][m][n] = (f32x4){0.f, 0.f, 0.f, 0.f};
        cur = nxt; cA = nA; cB = nB; ++ui;
        if constexpr (ALIGN_EPI) { if (wr == 1) PG8_BAR; }
    }
    PG8_WAIT_V(0);
    if constexpr (!ALIGN_EPI) { if (wr == 0) PG8_BAR; }
    PG8_BAR;
#undef PG8_SA
#undef PG8_SB
#undef PG8_STAGE
#undef PG8_LDA
#undef PG8_LDB
#undef PG8_MMA
#undef PG8_WAIT_V
#undef PG8_WAIT_L
#undef PG8_BAR
#undef PG8_SCHED
}
}

using pg8::Unit;
__device__ __forceinline__ u32x4 pack8(f32x4 a, f32x4 b) { u32x4 w; w.x = cvt_pk_bf16(a[0], a[1]); w.y = cvt_pk_bf16(a[2], a[3]); w.z = cvt_pk_bf16(b[0], b[1]); w.w = cvt_pk_bf16(b[2], b[3]); return w; }
__device__ __forceinline__ void rope8(f32x4& v0, f32x4& v1, f32x4 cs, f32x4 sn) {
    f32x4 a = v0, b = v1;
    v0[0] = a[0] * cs[0] - a[1] * sn[0]; v0[1] = a[1] * cs[0] + a[0] * sn[0];
    v0[2] = a[2] * cs[1] - a[3] * sn[1]; v0[3] = a[3] * cs[1] + a[2] * sn[1];
    v1[0] = b[0] * cs[2] - b[1] * sn[2]; v1[1] = b[1] * cs[2] + b[0] * sn[2];
    v1[2] = b[2] * cs[3] - b[3] * sn[3]; v1[3] = b[3] * cs[3] + b[2] * sn[3];
}
__device__ __forceinline__ float fr_max(float v) { v = fmaxf(v, __shfl_xor(v, 1)); v = fmaxf(v, __shfl_xor(v, 2)); v = fmaxf(v, __shfl_xor(v, 4)); v = fmaxf(v, __shfl_xor(v, 8)); return v; }
__device__ __forceinline__ float sq8f(f32x4 a, f32x4 b) { return (a[0] * a[0] + a[1] * a[1]) + (a[2] * a[2] + a[3] * a[3]) + (b[0] * b[0] + b[1] * b[1]) + (b[2] * b[2] + b[3] * b[3]); }
struct EpiIn {
    static constexpr bool PERM = true;
    unsigned char* ws;
    __device__ __forceinline__ void operator()(const f32x4 (&acc)[2][2][4][2], const Unit& u, int wr, int wc, int fr, int fq) const {
        const int row0 = u.pm * 256 + wr * 64 + fr, pn = u.pn, cl = wc * 32 + 8 * fq;
        bf16_t* KB = (bf16_t*)(ws + WS_KB); const float* COS = (const float*)(ws + WS_COS); const float* SIN = (const float*)(ws + WS_SIN);
        if (pn < 12) {
            bf16_t* base = (bf16_t*)(ws + WS_QA + (size_t)(pn >> 2) * (32 * MiB)); const int colt = (pn & 3) * 256 + cl; const float qsc = pn < 4 ? 0.125f * LOG2E : 1.f;
#pragma unroll
            for (int ai = 0; ai < 2; ++ai)
#pragma unroll
                for (int m = 0; m < 4; ++m) { bf16_t* rowp = base + (size_t)(row0 + ai * 128 + m * 16) * 1024 + colt;
#pragma unroll
                    for (int bj = 0; bj < 2; ++bj) *(u32x4*)(rowp + bj * 128) = pack8(acc[ai][bj][m][0] * qsc, acc[ai][bj][m][1] * qsc); }
            if (pn >= 4 && pn < 8) {
                float mx[2] = {0.f, 0.f};
#pragma unroll
                for (int ai = 0; ai < 2; ++ai)
#pragma unroll
                    for (int m = 0; m < 4; ++m)
#pragma unroll
                        for (int bj = 0; bj < 2; ++bj) { float q = sq8f(acc[ai][bj][m][0], acc[ai][bj][m][1]); q += __shfl_xor(q, 16); q += __shfl_xor(q, 32); mx[bj] = fmaxf(mx[bj], q); }
#pragma unroll
                for (int bj = 0; bj < 2; ++bj) { const float v = fr_max(mx[bj]); if (fr == 0 && fq == 0) atomicMax((unsigned*)(ws + WS_KMXA) + ((2 * (pn - 4) + bj) * 2 + (wc >> 1)) * 2 + (wc & 1), __float_as_uint(v)); }
            }
        } else if (pn < 15) {
            const bool isq = pn < 14; bf16_t* base = (bf16_t*)(ws + (isq ? WS_CQ : WS_CKV)); const int ld = isq ? QLR : KVLR, colt = isq ? (pn - 12) * 256 + cl : cl; float* ssq = (float*)(ws + (isq ? WS_SSQQ : WS_SSQKV));
#pragma unroll
            for (int ai = 0; ai < 2; ++ai)
#pragma unroll
                for (int m = 0; m < 4; ++m) { const int row = row0 + ai * 128 + m * 16; bf16_t* rowp = base + (size_t)row * ld + colt; float s = 0.f;
#pragma unroll
                    for (int bj = 0; bj < 2; ++bj) { const f32x4 a = acc[ai][bj][m][0], b = acc[ai][bj][m][1];
                        s += (a[0] * a[0] + a[1] * a[1]) + (a[2] * a[2] + a[3] * a[3]) + (b[0] * b[0] + b[1] * b[1]) + (b[2] * b[2] + b[3] * b[3]);
                        *(u32x4*)(rowp + bj * 128) = pack8(a, b); }
                    s += __shfl_xor(s, 16); s += __shfl_xor(s, 32);
                    if (fq == 0) atomicAdd(ssq + row, s); }
        } else {
            if (wc < 2) {
#pragma unroll
                for (int ai = 0; ai < 2; ++ai)
#pragma unroll
                    for (int m = 0; m < 4; ++m) { const int row = row0 + ai * 128 + m * 16; const int i0 = cl >> 1;
                        const f32x4 cs = *(const f32x4*)(COS + (size_t)row * 32 + i0), sn = *(const f32x4*)(SIN + (size_t)row * 32 + i0);
                        f32x4 a = acc[ai][0][m][0], b = acc[ai][0][m][1]; rope8(a, b, cs, sn); const u32x4 w = pack8(a, b);
                        bf16_t* rowp = KB + (size_t)row * NQB + 128 + cl;
#pragma unroll
                        for (int h = 0; h < 8; ++h) *(u32x4*)(rowp + h * 192) = w; }
                float mxr = 0.f;
#pragma unroll
                for (int ai = 0; ai < 2; ++ai)
#pragma unroll
                    for (int m = 0; m < 4; ++m) { float q = sq8f(acc[ai][0][m][0], acc[ai][0][m][1]); q += __shfl_xor(q, 16); q += __shfl_xor(q, 32); mxr = fmaxf(mxr, q); }
                mxr = fr_max(mxr); if (fr == 0 && fq == 0) atomicMax((unsigned*)(ws + WS_KMXR) + wc, __float_as_uint(mxr));
            }
        }
    }
};
struct EpiQB {
    static constexpr bool PERM = true;
    bf16_t* QB; const float *SSQ, *COS, *SIN;
    __device__ __forceinline__ void operator()(const f32x4 (&acc)[2][2][4][2], const Unit& u, int wr, int wc, int fr, int fq) const {
        const int row0 = u.pm * 256 + wr * 64 + fr;
#pragma unroll
        for (int ai = 0; ai < 2; ++ai)
#pragma unroll
            for (int m = 0; m < 4; ++m) { const int row = row0 + ai * 128 + m * 16; const float rstd = rsqrtf(SSQ[row] * (1.f / QLR) + EPS) * (0.07216878364870322f * LOG2E);
#pragma unroll
                for (int bj = 0; bj < 2; ++bj) { const int colw = u.pn * 256 + bj * 128 + wc * 32, hw = colw / 192, w = colw - hw * 192, col = colw + 8 * fq;
                    f32x4 a = acc[ai][bj][m][0] * rstd, b = acc[ai][bj][m][1] * rstd;
                    if (w >= 128) { const int i0 = ((w - 128) >> 1) + 4 * fq;
                        const f32x4 cs = *(const f32x4*)(COS + (size_t)row * 32 + i0), sn = *(const f32x4*)(SIN + (size_t)row * 32 + i0); rope8(a, b, cs, sn); }
                    *(u32x4*)(QB + (size_t)row * NQB + col) = pack8(a, b); } }
    }
};
struct EpiKV {
    static constexpr bool PERM = true;
    bf16_t *KB, *VB; const float* SSQ; unsigned* KMX;
    __device__ __forceinline__ void operator()(const f32x4 (&acc)[2][2][4][2], const Unit& u, int wr, int wc, int fr, int fq) const {
        const int row0 = u.pm * 256 + wr * 64 + fr, h = u.pn, cl = wc * 32 + 8 * fq; float mx = 0.f;
#pragma unroll
        for (int ai = 0; ai < 2; ++ai)
#pragma unroll
            for (int m = 0; m < 4; ++m) { const int row = row0 + ai * 128 + m * 16; const float rstd = rsqrtf(SSQ[row] * (1.f / KVLR) + EPS);
                { float q = sq8f(acc[ai][0][m][0] * rstd, acc[ai][0][m][1] * rstd); q += __shfl_xor(q, 16); q += __shfl_xor(q, 32); mx = fmaxf(mx, q); }
                *(u32x4*)(KB + (size_t)row * NQB + h * 192 + cl) = pack8(acc[ai][0][m][0] * rstd, acc[ai][0][m][1] * rstd);
                *(u32x4*)(VB + (size_t)row * 1024 + h * 128 + cl) = pack8(acc[ai][1][m][0] * rstd, acc[ai][1][m][1] * rstd); }
        mx = fr_max(mx); if (fr == 0 && fq == 0) atomicMax(KMX + h * 4 + wc, __float_as_uint(mx));
    }
};
struct EpiRes {
    static constexpr bool PERM = false;
    const float* base; float* out;
    __device__ __forceinline__ void operator()(const f32x4 (&acc)[2][2][4][2], const Unit& u, int wr, int wc, int fr, int fq) const {
        const int row0 = u.pm * 256 + wr * 64 + fr, col0 = u.pn * 256 + wc * 32 + 4 * fq;
#pragma unroll
        for (int ai = 0; ai < 2; ++ai)
#pragma unroll
            for (int m = 0; m < 4; ++m) { const size_t off = (size_t)(row0 + ai * 128 + m * 16) * DM + col0;
#pragma unroll
                for (int bj = 0; bj < 2; ++bj)
#pragma unroll
                    for (int n = 0; n < 2; ++n) { const f32x4 bs = *(const f32x4*)(base + off + bj * 128 + n * 16); *(f32x4*)(out + off + bj * 128 + n * 16) = bs + acc[ai][bj][m][n]; } }
    }
};
struct EpiGU {
    static constexpr bool PERM = true;
    bf16_t* ACT;
    __device__ __forceinline__ void operator()(const f32x4 (&acc)[2][2][4][2], const Unit& u, int wr, int wc, int fr, int fq) const {
        const int row0 = u.pm * 256 + wr * 64 + fr, col = u.pn * 128 + wc * 32 + 8 * fq;
#pragma unroll
        for (int ai = 0; ai < 2; ++ai)
#pragma unroll
            for (int m = 0; m < 4; ++m) { f32x4 r[2];
#pragma unroll
                for (int n = 0; n < 2; ++n) { const f32x4 g = acc[ai][0][m][n], up = acc[ai][1][m][n];
#pragma unroll
                    for (int j = 0; j < 4; ++j) r[n][j] = g[j] * up[j] * __builtin_amdgcn_rcpf(1.f + __builtin_amdgcn_exp2f(-g[j] * LOG2E)); }
                *(u32x4*)(ACT + (size_t)(row0 + ai * 128 + m * 16) * DFF + col) = pack8(r[0], r[1]); }
    }
};

namespace att {
constexpr int NW = 8, QBLK = 32, KVBLK = 64;
constexpr float THR2 = 8.f * LOG2E;
constexpr int SHM_V = KVBLK * 128 * 2;
constexpr int OFF_K = 2 * SHM_V, OFF_WS = OFF_K + 2 * 64 * 192 * 2, OFF_TBL = OFF_WS + NW * 256, OFF_QL = OFF_TBL + 2048, ATT_LDS = OFF_QL + NW * 8192;
constexpr int OFF_KA = 65536, OFF_WSA = 98304, OFF_TBLA = 100352;
constexpr int OFF_K3 = 3 * SHM_V, OFF_WS3 = OFF_K3 + 3 * 24576, OFF_TBL3 = OFF_WS3 + NW * 256;
#ifdef NO_SBAR
#define SBAR() do {} while (0)
#else
#define SBAR() __builtin_amdgcn_sched_barrier(0)
#endif
__device__ __forceinline__ int crow(int r, int hi) { return (r & 3) + 8 * (r >> 2) + 4 * hi; }
template <int DQK> __device__ __forceinline__ int koff(int row, int c) { const int s = ((row >> 1) & 1) | (((row >> 3) & 3) << 1); return row * (DQK * 2) + ((c ^ s) << 4); }
__device__ __forceinline__ int v_st(int k, int c) { const int kk = (k & ~0xC) | ((k & 4) << 1) | ((k & 8) >> 1); return ((kk >> 3) * 4 + (c >> 5)) * 512 + ((kk & 7) * 32 + (c & 31)) * 2; }
__device__ __forceinline__ int v_rd_base(int lane) { return ((lane & 3) << 3) | (((lane >> 2) & 3) << 6) | (((lane >> 4) & 1) << 5) | (((lane >> 5) & 1) << 8); }
constexpr int v_rd_off(int d0, int ks, int half) { return d0 * 512 + ks * 4096 + half * 2048; }
template <int OFF> __device__ __forceinline__ s16x4 tr_read(int vb) { s16x4 r; asm volatile("ds_read_b64_tr_b16 %0, %1 offset:%2" : "=&v"(r) : "v"(vb), "i"(OFF) : "memory"); return r; }
template <int D0> __device__ __forceinline__ void pv_one(f32x16& od, int vb, bf16x8 pa0, bf16x8 pa1, bf16x8 pa2, bf16x8 pa3) {
    s16x4 l0 = tr_read<v_rd_off(D0, 0, 0)>(vb), h0 = tr_read<v_rd_off(D0, 0, 1)>(vb), l1 = tr_read<v_rd_off(D0, 1, 0)>(vb), h1 = tr_read<v_rd_off(D0, 1, 1)>(vb);
    s16x4 l2 = tr_read<v_rd_off(D0, 2, 0)>(vb), h2 = tr_read<v_rd_off(D0, 2, 1)>(vb), l3 = tr_read<v_rd_off(D0, 3, 0)>(vb), h3 = tr_read<v_rd_off(D0, 3, 1)>(vb);
#ifdef NO_SBAR
    asm volatile("s_waitcnt lgkmcnt(0)" : "+v"(l0), "+v"(h0), "+v"(l1), "+v"(h1), "+v"(l2), "+v"(h2), "+v"(l3), "+v"(h3) :: "memory");
#else
    asm volatile("s_waitcnt lgkmcnt(0)" ::: "memory"); SBAR();
#endif
#define PK(L, H) (bf16x8){L[0], L[1], L[2], L[3], H[0], H[1], H[2], H[3]}
    od = __builtin_amdgcn_mfma_f32_32x32x16_bf16(pa0, PK(l0, h0), od, 0, 0, 0);
    od = __builtin_amdgcn_mfma_f32_32x32x16_bf16(pa1, PK(l1, h1), od, 0, 0, 0);
    od = __builtin_amdgcn_mfma_f32_32x32x16_bf16(pa2, PK(l2, h2), od, 0, 0, 0);
    od = __builtin_amdgcn_mfma_f32_32x32x16_bf16(pa3, PK(l3, h3), od, 0, 0, 0);
#undef PK
}
__device__ __forceinline__ void pv_d0(f32x16 (&o)[4], int vb, bf16x8 pa0, bf16x8 pa1, bf16x8 pa2, bf16x8 pa3) {
    pv_one<0>(o[0], vb, pa0, pa1, pa2, pa3); pv_one<1>(o[1], vb, pa0, pa1, pa2, pa3); pv_one<2>(o[2], vb, pa0, pa1, pa2, pa3); pv_one<3>(o[3], vb, pa0, pa1, pa2, pa3);
}
template <bool BAND>
__device__ __forceinline__ void partialSM(f32x16& p0, f32x16& p1, float& m_reg, float& mn, float& alpha, float C, float cb, const LAS float* tbl, int relb, int hi) {
    if constexpr (BAND) {
#pragma unroll
        for (int r = 0; r < 16; ++r) { int i0 = relb + crow(r, hi), i1 = i0 + 32; i0 = min(max(i0, 0), 256); i1 = min(max(i1, 0), 256);
            p0[r] = fmaf(p0[r], C, tbl[i0]); p1[r] = fmaf(p1[r], C, tbl[i1]); }
    }
    float pmax = p0[0];
#pragma unroll
    for (int r = 1; r < 16; ++r) pmax = fmaxf(pmax, p0[r]);
#pragma unroll
    for (int r = 0; r < 16; ++r) pmax = fmaxf(pmax, p1[r]);
    { auto rr = __builtin_amdgcn_permlane32_swap(__float_as_uint(pmax), __float_as_uint(pmax), false, false);
      pmax = fmaxf(__uint_as_float(rr[0]), __uint_as_float(rr[1])); }
    const float ymax = BAND ? pmax : fmaf(pmax, C, cb);
    if (__builtin_expect(__all(ymax - m_reg <= THR2), 1)) { mn = m_reg; alpha = 1.f; }
    else { mn = fmaxf(m_reg, ymax); alpha = __builtin_amdgcn_exp2f(m_reg - mn); m_reg = mn; }
    if constexpr (BAND) {
#pragma unroll
        for (int r = 0; r < 16; ++r) { p0[r] -= mn; p1[r] -= mn; }
    } else {
        const float a = cb - mn;
#pragma unroll
        for (int r = 0; r < 16; ++r) { p0[r] = fmaf(p0[r], C, a); p1[r] = fmaf(p1[r], C, a); }
    }
#pragma unroll
    for (int r = 0; r < 16; ++r) p0[r] = __builtin_amdgcn_exp2f(p0[r]);
}
__device__ __forceinline__ void finishSM(f32x16& p0, f32x16& p1, float alpha, float& l_reg, bf16x8& pa0, bf16x8& pa1, bf16x8& pa2, bf16x8& pa3) {
#pragma unroll
    for (int r = 0; r < 16; ++r) p1[r] = __builtin_amdgcn_exp2f(p1[r]);
    float ps = 0;
#pragma unroll
    for (int r = 0; r < 16; ++r) ps += p0[r];
#pragma unroll
    for (int r = 0; r < 16; ++r) ps += p1[r];
    { auto rr = __builtin_amdgcn_permlane32_swap(__float_as_uint(ps), __float_as_uint(ps), false, false);
      ps = __uint_as_float(rr[0]) + __uint_as_float(rr[1]); }
    l_reg = l_reg * alpha + ps;
#define PK4(P, BASE, OUT) do { unsigned a0 = cvt_pk_bf16(P[BASE + 0], P[BASE + 1]), a1 = cvt_pk_bf16(P[BASE + 2], P[BASE + 3]);   \
    unsigned b0 = cvt_pk_bf16(P[BASE + 4], P[BASE + 5]), b1 = cvt_pk_bf16(P[BASE + 6], P[BASE + 7]);                              \
    auto r0 = __builtin_amdgcn_permlane32_swap(a0, b0, false, false); auto r1 = __builtin_amdgcn_permlane32_swap(a1, b1, false, false); \
    u32x4 w = {r0[0], r1[0], r0[1], r1[1]}; OUT = *reinterpret_cast<bf16x8*>(&w); } while (0)
    PK4(p0, 0, pa0); PK4(p0, 8, pa1); PK4(p1, 0, pa2); PK4(p1, 8, pa3);
#undef PK4
}
template <int DQK, int QREG>
__device__ __forceinline__ void qkt(f32x16& p0, f32x16& p1, const LAS unsigned char* Ks, const bf16x8 (&qr)[QREG], const LAS unsigned char* ql, int r32, int hi) {
    p0 = f32x16{}; p1 = f32x16{};
#pragma unroll
    for (int d0 = 0; d0 < DQK / 16; ++d0) { const int c = d0 * 2 + hi;
        const bf16x8 b0 = *(const LAS bf16x8*)(Ks + koff<DQK>(r32, c));
        const bf16x8 b1 = *(const LAS bf16x8*)(Ks + koff<DQK>(32 + r32, c));
        bf16x8 q; if (d0 < QREG) q = qr[d0 < QREG ? d0 : 0]; else q = *(const LAS bf16x8*)(ql + (d0 - QREG) * 1024);
        p0 = __builtin_amdgcn_mfma_f32_32x32x16_bf16(b0, q, p0, 0, 0, 0);
        p1 = __builtin_amdgcn_mfma_f32_32x32x16_bf16(b1, q, p1, 0, 0, 0); }
}

template <int OFF> __device__ __forceinline__ bf16x8 ldsr128(int addr) { bf16x8 r; asm volatile("ds_read_b128 %0, %1 offset:%2" : "=v"(r) : "v"(addr), "i"(OFF) : "memory"); return r; }
template <int BUF, int QREG>
__device__ __forceinline__ void qkt192(f32x16& p0, f32x16& p1, const int (&kb)[4], const bf16x8 (&qr)[QREG], const LAS unsigned char* ql) {
    p0 = f32x16{}; p1 = f32x16{};
#define QKT_G(G) do { \
        bf16x8 a0 = ldsr128<BUF * 24576 + 128 * G>(kb[0]), b0 = ldsr128<BUF * 24576 + 128 * G + 12288>(kb[0]); \
        bf16x8 a1 = ldsr128<BUF * 24576 + 128 * G>(kb[1]), b1 = ldsr128<BUF * 24576 + 128 * G + 12288>(kb[1]); \
        bf16x8 a2 = ldsr128<BUF * 24576 + 128 * G>(kb[2]), b2 = ldsr128<BUF * 24576 + 128 * G + 12288>(kb[2]); \
        bf16x8 a3 = ldsr128<BUF * 24576 + 128 * G>(kb[3]), b3 = ldsr128<BUF * 24576 + 128 * G + 12288>(kb[3]); \
        bf16x8 q0, q1, q2, q3; \
        if (4 * G + 0 < QREG) q0 = qr[4 * G + 0 < QREG ? 4 * G + 0 : 0]; else q0 = *(const LAS bf16x8*)(ql + (4 * G + 0 - QREG) * 1024); \
        if (4 * G + 1 < QREG) q1 = qr[4 * G + 1 < QREG ? 4 * G + 1 : 0]; else q1 = *(const LAS bf16x8*)(ql + (4 * G + 1 - QREG) * 1024); \
        if (4 * G + 2 < QREG) q2 = qr[4 * G + 2 < QREG ? 4 * G + 2 : 0]; else q2 = *(const LAS bf16x8*)(ql + (4 * G + 2 - QREG) * 1024); \
        if (4 * G + 3 < QREG) q3 = qr[4 * G + 3 < QREG ? 4 * G + 3 : 0]; else q3 = *(const LAS bf16x8*)(ql + (4 * G + 3 - QREG) * 1024); \
        asm volatile("s_waitcnt lgkmcnt(0)" : "+v"(a0), "+v"(b0), "+v"(a1), "+v"(b1), "+v"(a2), "+v"(b2), "+v"(a3), "+v"(b3) :: "memory"); \
        p0 = __builtin_amdgcn_mfma_f32_32x32x16_bf16(a0, q0, p0, 0, 0, 0); p1 = __builtin_amdgcn_mfma_f32_32x32x16_bf16(b0, q0, p1, 0, 0, 0); \
        p0 = __builtin_amdgcn_mfma_f32_32x32x16_bf16(a1, q1, p0, 0, 0, 0); p1 = __builtin_amdgcn_mfma_f32_32x32x16_bf16(b1, q1, p1, 0, 0, 0); \
        p0 = __builtin_amdgcn_mfma_f32_32x32x16_bf16(a2, q2, p0, 0, 0, 0); p1 = __builtin_amdgcn_mfma_f32_32x32x16_bf16(b2, q2, p1, 0, 0, 0); \
        p0 = __builtin_amdgcn_mfma_f32_32x32x16_bf16(a3, q3, p0, 0, 0, 0); p1 = __builtin_amdgcn_mfma_f32_32x32x16_bf16(b3, q3, p1, 0, 0, 0); } while (0)
    QKT_G(0); QKT_G(1); QKT_G(2);
#undef QKT_G
}
template <int DQK, bool BIAS, int ldq, int ldk, int ldv, int SDEPTH, int QREG>
__device__ __forceinline__ void attn_body(const bf16_t* __restrict__ Qb, const bf16_t* __restrict__ Kh, const bf16_t* __restrict__ Vh,
                                          LAS unsigned char* lds, float C, int q0, float cb_lo, float cb_hi, f32x16 (&o)[4]) {
    constexpr int NK = DQK / 64, CPR = DQK / 8, SHM_K = 64 * DQK * 2, NLD = 2 + NK;
    int tid_ = threadIdx.x; asm volatile("" : "+v"(tid_));
    const int tid = tid_, wid = tid >> 6, lane = tid & 63, r32 = lane & 31, hi = lane >> 5;
    LAS unsigned char* V_lds = lds; LAS unsigned char* K_lds = lds + OFF_K;
    LAS float* ws = (LAS float*)(lds + OFF_WS) + wid * 64; LAS float* li_l = ws; LAS float* al_l = ws + 32;
    const LAS float* tbl = (const LAS float*)(lds + OFF_TBL);
    float m_reg = -1e30f, l_reg = 0;
#pragma unroll
    for (int d = 0; d < 4; ++d) o[d] = f32x16{};
    bf16x8 qr[QREG];
    const bf16_t* Qw = Qb + (size_t)(wid * QBLK + r32) * ldq + hi * 8;
    LAS unsigned char* ql = lds + OFF_QL + wid * 8192 + lane * 16;
#pragma unroll
    for (int d0 = 0; d0 < DQK / 16; ++d0) { const bf16x8 q = *(const bf16x8*)(Qw + d0 * 16); if (d0 < QREG) qr[d0 < QREG ? d0 : 0] = q; else *(LAS bf16x8*)(ql + (d0 - QREG) * 1024) = q; }
    const int sr = tid >> 4, sc = (tid & 15) * 8, vst0 = v_st(sr, sc), vst1 = vst0 + 8192;
    unsigned kgo[NK]; int klo[NK];
#pragma unroll
    for (int i = 0; i < NK; ++i) { const int id = tid + 512 * i, row = id / CPR, c = id - row * CPR; kgo[i] = (unsigned)(row * ldk + c * 8) * 2u; klo[i] = koff<DQK>(row, c); }
    const unsigned vgo0 = (unsigned)(sr * ldv + sc) * 2u, vgo1 = vgo0 + (unsigned)(32 * ldv * 2);
    const int vb0 = (int)(uintptr_t)V_lds + v_rd_base(lane);
    int kb4[4];
#pragma unroll
    for (int e = 0; e < 4; ++e) kb4[e] = (int)(uintptr_t)K_lds + koff<DQK>(r32, 2 * e + hi);
#define QKT(P0, P1, BUF) do { if constexpr (DQK == 192) qkt192<BUF, QREG>(P0, P1, kb4, qr, ql); else qkt<DQK, QREG>(P0, P1, K_lds + BUF * SHM_K, qr, ql, r32, hi); } while (0)
    struct Slot { bf16x8 v0, v1, k[NK]; } slots[SDEPTH];
#define sl0 slots[0]
#define sl1 slots[SDEPTH - 1]
    const int qabs = q0 + wid * QBLK + r32;
#define SLOAD(sl, k0) do { const char* vb_ = (const char*)(Vh + (size_t)(k0) * ldv); const char* kb_ = (const char*)(Kh + (size_t)(k0) * ldk); \
    sl.v0 = *(const bf16x8*)(vb_ + vgo0); sl.v1 = *(const bf16x8*)(vb_ + vgo1); \
    _Pragma("unroll") for (int _i = 0; _i < NK; ++_i) sl.k[_i] = *(const bf16x8*)(kb_ + kgo[_i]); } while (0)
#define SWRITE(b, sl) do { *(LAS bf16x8*)(V_lds + (b) * SHM_V + vst0) = sl.v0; *(LAS bf16x8*)(V_lds + (b) * SHM_V + vst1) = sl.v1; \
    _Pragma("unroll") for (int _i = 0; _i < NK; ++_i) *(LAS bf16x8*)(K_lds + (b) * SHM_K + klo[_i]) = sl.k[_i]; } while (0)
#define SWAIT() do { if constexpr (SDEPTH == 1) asm volatile("s_waitcnt vmcnt(0)" ::: "memory"); else if constexpr (NLD == 3) asm volatile("s_waitcnt vmcnt(3)" ::: "memory"); else asm volatile("s_waitcnt vmcnt(5)" ::: "memory"); } while (0)
#define RESC(a) do { if (__any((a) < 1.f)) { if (hi == 0) al_l[r32] = (a); asm volatile("s_waitcnt lgkmcnt(0)" ::: "memory"); \
    _Pragma("unroll") for (int d = 0; d < 4; ++d) _Pragma("unroll") for (int r = 0; r < 16; ++r) o[d][r] *= al_l[crow(r, hi)]; } } while (0)
#define PSM(P0, P1, MN, AL, t) do { if constexpr (BIAS) { const int k0_ = (t) * KVBLK; \
        if (k0_ <= q0 - 191 || k0_ >= q0 + 383) partialSM<false>(P0, P1, m_reg, MN, AL, C, k0_ < q0 ? cb_lo : cb_hi, tbl, 0, hi); \
        else partialSM<true>(P0, P1, m_reg, MN, AL, C, 0.f, tbl, k0_ - qabs + 128, hi); } \
      else partialSM<false>(P0, P1, m_reg, MN, AL, C, 0.f, tbl, 0, hi); } while (0)
    f32x16 pA0, pA1, pB0, pB1; float mnA, mnB, alA, alB; bf16x8 pa0, pa1, pa2, pa3; const int NT = S / KVBLK;
    if (wid >= 4) __builtin_amdgcn_s_setprio(1);
    SLOAD(sl0, 0); asm volatile("s_waitcnt vmcnt(0)" ::: "memory"); SWRITE(0, sl0); __syncthreads();
    QKT(pA0, pA1, 0); PSM(pA0, pA1, mnA, alA, 0);
    SLOAD(sl1, KVBLK); if constexpr (SDEPTH == 2) SLOAD(sl0, 2 * KVBLK);
    SWAIT(); SWRITE(1, sl1); __syncthreads();
    for (int j = 1; j + 1 < NT; j += 2) {
        SBAR(); QKT(pB0, pB1, 1);
        finishSM(pA0, pA1, alA, l_reg, pa0, pa1, pa2, pa3); SBAR();
        SLOAD(sl1, (j + SDEPTH) * KVBLK); SBAR();
        pv_d0(o, vb0, pa0, pa1, pa2, pa3); PSM(pB0, pB1, mnB, alB, j);
        __syncthreads(); SWAIT(); SWRITE(0, sl0);
        RESC(alB); __syncthreads();
        SBAR(); QKT(pA0, pA1, 0);
        finishSM(pB0, pB1, alB, l_reg, pa0, pa1, pa2, pa3); SBAR();
        if (SDEPTH == 1 || j + 3 < NT) SLOAD(sl0, (j + 1 + SDEPTH) * KVBLK); SBAR();
        pv_d0(o, vb0 + SHM_V, pa0, pa1, pa2, pa3); PSM(pA0, pA1, mnA, alA, j + 1);
        __syncthreads(); SWAIT(); SWRITE(1, sl1);
        RESC(alA); __syncthreads();
    }
    SBAR(); QKT(pB0, pB1, 1);
    finishSM(pA0, pA1, alA, l_reg, pa0, pa1, pa2, pa3); SBAR();
    pv_d0(o, vb0, pa0, pa1, pa2, pa3); PSM(pB0, pB1, mnB, alB, NT - 1);
    __syncthreads(); RESC(alB);
    finishSM(pB0, pB1, alB, l_reg, pa0, pa1, pa2, pa3); SBAR();
    pv_d0(o, vb0 + SHM_V, pa0, pa1, pa2, pa3);
    __builtin_amdgcn_s_setprio(0);
    if (hi == 0) li_l[r32] = l_reg; asm volatile("s_waitcnt lgkmcnt(0)" ::: "memory");
#pragma unroll
    for (int r = 0; r < 16; ++r) { const float rl = __builtin_amdgcn_rcpf(li_l[crow(r, hi)]);
#pragma unroll
        for (int d = 0; d < 4; ++d) o[d][r] *= rl; }
#undef SLOAD
#undef sl0
#undef sl1
#undef SWRITE
#undef SWAIT
#undef RESC
#undef PSM
#undef QKT
}

template <int DQK, bool BIAS, int ldq, int ldk, int ldv, int QREG>
__device__ __forceinline__ void attn_body1(const bf16_t* __restrict__ Qb, const bf16_t* __restrict__ Kh, const bf16_t* __restrict__ Vh,
                                           LAS unsigned char* lds, float C, int q0, float cb_lo, float cb_hi, f32x16 (&o)[4]) {
    constexpr int NK = DQK / 64, CPR = DQK / 8, SHM_K = 64 * DQK * 2;
    int tid_ = threadIdx.x; asm volatile("" : "+v"(tid_));
    const int tid = tid_, wid = tid >> 6, lane = tid & 63, r32 = lane & 31, hi = lane >> 5;
    LAS unsigned char* V_lds = lds; LAS unsigned char* K_lds = lds + OFF_K;
    LAS float* ws = (LAS float*)(lds + OFF_WS) + wid * 64; LAS float* li_l = ws; LAS float* al_l = ws + 32;
    const LAS float* tbl = (const LAS float*)(lds + OFF_TBL);
    float m_reg = -1e30f, l_reg = 0;
#pragma unroll
    for (int d = 0; d < 4; ++d) o[d] = f32x16{};
    bf16x8 qr[QREG];
    const bf16_t* Qw = Qb + (size_t)(wid * QBLK + r32) * ldq + hi * 8;
    LAS unsigned char* ql = lds + OFF_QL + wid * 8192 + lane * 16;
#pragma unroll
    for (int d0 = 0; d0 < DQK / 16; ++d0) { const bf16x8 q = *(const bf16x8*)(Qw + d0 * 16); if (d0 < QREG) qr[d0 < QREG ? d0 : 0] = q; else *(LAS bf16x8*)(ql + (d0 - QREG) * 1024) = q; }
    const int sr = tid >> 4, sc = (tid & 15) * 8, vst0 = v_st(sr, sc), vst1 = vst0 + 8192;
    unsigned kgo[NK]; int klo[NK];
#pragma unroll
    for (int i = 0; i < NK; ++i) { const int id = tid + 512 * i, row = id / CPR, c = id - row * CPR; kgo[i] = (unsigned)(row * ldk + c * 8) * 2u; klo[i] = koff<DQK>(row, c); }
    const unsigned vgo0 = (unsigned)(sr * ldv + sc) * 2u, vgo1 = vgo0 + (unsigned)(32 * ldv * 2);
    const int vb0 = (int)(uintptr_t)V_lds + v_rd_base(lane);
    bf16x8 sv0, sv1, sk[NK];
    const int qabs = q0 + wid * QBLK + r32;
#define SLOAD1(k0) do { const char* vb_ = (const char*)(Vh + (size_t)(k0) * ldv); const char* kb_ = (const char*)(Kh + (size_t)(k0) * ldk); \
    sv0 = *(const bf16x8*)(vb_ + vgo0); sv1 = *(const bf16x8*)(vb_ + vgo1); \
    _Pragma("unroll") for (int _i = 0; _i < NK; ++_i) sk[_i] = *(const bf16x8*)(kb_ + kgo[_i]); } while (0)
#define SWRITE1(b) do { *(LAS bf16x8*)(V_lds + (b) * SHM_V + vst0) = sv0; *(LAS bf16x8*)(V_lds + (b) * SHM_V + vst1) = sv1; \
    _Pragma("unroll") for (int _i = 0; _i < NK; ++_i) *(LAS bf16x8*)(K_lds + (b) * SHM_K + klo[_i]) = sk[_i]; } while (0)
    constexpr int NT = S / KVBLK;
    if (wid >= 4) __builtin_amdgcn_s_setprio(1);
    SLOAD1(0); asm volatile("s_waitcnt vmcnt(0)" ::: "memory"); SWRITE1(0); __syncthreads();
    for (int j = 0; j < NT; ++j) {
        const int b = j & 1;
        if (j + 1 < NT) SLOAD1((j + 1) * KVBLK);
        f32x16 p0, p1; float mn, al; bf16x8 pa0, pa1, pa2, pa3;
        qkt<DQK, QREG>(p0, p1, K_lds + b * SHM_K, qr, ql, r32, hi);
        if constexpr (BIAS) { const int k0_ = j * KVBLK;
            if (k0_ <= q0 - 191) partialSM<false>(p0, p1, m_reg, mn, al, C, cb_lo, tbl, 0, hi);
            else if (k0_ >= q0 + 383) partialSM<false>(p0, p1, m_reg, mn, al, C, cb_hi, tbl, 0, hi);
            else partialSM<true>(p0, p1, m_reg, mn, al, C, 0.f, tbl, k0_ - qabs + 128, hi); }
        else partialSM<false>(p0, p1, m_reg, mn, al, C, 0.f, tbl, 0, hi);
        finishSM(p0, p1, al, l_reg, pa0, pa1, pa2, pa3);
        if (__any(al < 1.f)) { if (hi == 0) al_l[r32] = al; asm volatile("s_waitcnt lgkmcnt(0)" ::: "memory");
#pragma unroll
            for (int d = 0; d < 4; ++d)
#pragma unroll
                for (int r = 0; r < 16; ++r) o[d][r] *= al_l[crow(r, hi)]; }
        pv_d0(o, vb0 + b * SHM_V, pa0, pa1, pa2, pa3);
        if (j + 1 < NT) SWRITE1(b ^ 1);
        __syncthreads();
    }
    __builtin_amdgcn_s_setprio(0);
    if (hi == 0) li_l[r32] = l_reg; asm volatile("s_waitcnt lgkmcnt(0)" ::: "memory");
#pragma unroll
    for (int r = 0; r < 16; ++r) { const float rl = __builtin_amdgcn_rcpf(li_l[crow(r, hi)]);
#pragma unroll
        for (int d = 0; d < 4; ++d) o[d][r] *= rl; }
#undef SLOAD1
#undef SWRITE1
}


template <int BUF>
__device__ __forceinline__ void qkt192n(f32x16& p0, f32x16& p1, const int (&kb)[4], const bf16x8 (&qr)[12], const f32x16& nm) {
#define QKT_G(G) do { \
        bf16x8 a0 = ldsr128<BUF * 24576 + 128 * G>(kb[0]), b0 = ldsr128<BUF * 24576 + 128 * G + 12288>(kb[0]); \
        bf16x8 a1 = ldsr128<BUF * 24576 + 128 * G>(kb[1]), b1 = ldsr128<BUF * 24576 + 128 * G + 12288>(kb[1]); \
        bf16x8 a2 = ldsr128<BUF * 24576 + 128 * G>(kb[2]), b2 = ldsr128<BUF * 24576 + 128 * G + 12288>(kb[2]); \
        bf16x8 a3 = ldsr128<BUF * 24576 + 128 * G>(kb[3]), b3 = ldsr128<BUF * 24576 + 128 * G + 12288>(kb[3]); \
        asm volatile("s_waitcnt lgkmcnt(0)" : "+v"(a0), "+v"(b0), "+v"(a1), "+v"(b1), "+v"(a2), "+v"(b2), "+v"(a3), "+v"(b3) :: "memory"); \
        p0 = __builtin_amdgcn_mfma_f32_32x32x16_bf16(a0, qr[4 * G + 0], G == 0 ? nm : p0, 0, 0, 0); p1 = __builtin_amdgcn_mfma_f32_32x32x16_bf16(b0, qr[4 * G + 0], G == 0 ? nm : p1, 0, 0, 0); \
        p0 = __builtin_amdgcn_mfma_f32_32x32x16_bf16(a1, qr[4 * G + 1], p0, 0, 0, 0); p1 = __builtin_amdgcn_mfma_f32_32x32x16_bf16(b1, qr[4 * G + 1], p1, 0, 0, 0); \
        p0 = __builtin_amdgcn_mfma_f32_32x32x16_bf16(a2, qr[4 * G + 2], p0, 0, 0, 0); p1 = __builtin_amdgcn_mfma_f32_32x32x16_bf16(b2, qr[4 * G + 2], p1, 0, 0, 0); \
        p0 = __builtin_amdgcn_mfma_f32_32x32x16_bf16(a3, qr[4 * G + 3], p0, 0, 0, 0); p1 = __builtin_amdgcn_mfma_f32_32x32x16_bf16(b3, qr[4 * G + 3], p1, 0, 0, 0); } while (0)
    QKT_G(0); QKT_G(1); QKT_G(2);
#undef QKT_G
}
__device__ __forceinline__ float sq8(u32x4 w) {
    float s = 0.f;
#pragma unroll
    for (int e = 0; e < 4; ++e) { const float lo = __uint_as_float(w[e] << 16), hi = __uint_as_float(w[e] & 0xffff0000u); s = fmaf(lo, lo, s); s = fmaf(hi, hi, s); }
    return s;
}
template <int DQK, bool BIAS, int ldq, int ldk, int ldv>
__device__ __forceinline__ void attn_f(const bf16_t* __restrict__ Qb, const bf16_t* __restrict__ Kh, const bf16_t* __restrict__ Vh,
                                       LAS unsigned char* lds, int q0, float cb_lo, float cb_hi, float kmax, float bmax, f32x16 (&o)[4]) {
    constexpr int RING = (DQK == 192) ? 3 : 2;
    constexpr int NK = DQK / 64, CPR = DQK / 8, SHM_K = (RING == 3) ? 24576 : 64 * DQK * 2, QREG = DQK / 16, NT = S / KVBLK;
    constexpr bool KPERM = (DQK == 64);
    int tid_ = threadIdx.x; asm volatile("" : "+v"(tid_));
    const int tid = tid_, wid = __builtin_amdgcn_readfirstlane(tid >> 6), lane = tid & 63, r32 = lane & 31, hi = lane >> 5;
    LAS unsigned char* V_lds = lds; LAS unsigned char* K_lds = lds + (RING == 3 ? OFF_K3 : OFF_K);
    LAS float* ws = (LAS float*)(lds + (RING == 3 ? OFF_WS3 : OFF_WS)) + wid * 64; LAS float* li_l = ws;
    const LAS float* tbl = (const LAS float*)(lds + OFF_TBL);
    float l_reg = 0.f;
#pragma unroll
    for (int d = 0; d < 4; ++d) o[d] = f32x16{};
    bf16x8 qr[QREG];
    const bf16_t* Qw = Qb + (size_t)(wid * QBLK + r32) * ldq + hi * 8;
    float qs = 0.f;
#pragma unroll
    for (int d0 = 0; d0 < QREG; ++d0) { qr[d0] = *(const bf16x8*)(Qw + d0 * 16); qs += sq8(__builtin_bit_cast(u32x4, qr[d0])); }
    { auto rr = __builtin_amdgcn_permlane32_swap(__float_as_uint(qs), __float_as_uint(qs), false, false); qs = __uint_as_float(rr[0]) + __uint_as_float(rr[1]); }
    const float nm_ref = -(sqrtf(qs) * kmax + bmax);
    f32x16 nm;
#pragma unroll
    for (int r = 0; r < 16; ++r) nm[r] = nm_ref;
    unsigned kgo[NK], vgo[2];
#pragma unroll
    for (int i = 0; i < NK; ++i) { const int p = (i * 8 + wid) * 64 + lane, rho = p / CPR, cph = p - rho * CPR, sw = ((rho >> 1) & 1) | (((rho >> 3) & 3) << 1), c = cph ^ sw;
        const int k = KPERM ? ((rho & ~0xC) | ((rho & 4) << 1) | ((rho & 8) >> 1)) : rho; kgo[i] = (unsigned)(k * ldk + c * 8) * 2u; }
#pragma unroll
    for (int i = 0; i < 2; ++i) { const int p = (i * 8 + wid) * 64 + lane, sub = p >> 5, w = p & 31, kk = (sub >> 2) * 8 + (w >> 2), k = (kk & ~0xC) | ((kk & 4) << 1) | ((kk & 8) >> 1), col = (sub & 3) * 32 + (w & 3) * 8;
        vgo[i] = (unsigned)(k * ldv + col) * 2u; }
    const int vb0 = (int)(uintptr_t)V_lds + v_rd_base(lane);
    const int qabs = q0 + wid * QBLK + r32;
    int kb4[4];
#pragma unroll
    for (int e = 0; e < 4; ++e) kb4[e] = (int)(uintptr_t)K_lds + koff<DQK>(r32, 2 * e + hi);
    const __amdgpu_buffer_rsrc_t krs = __builtin_amdgcn_make_buffer_rsrc((void*)Kh, 0, 0x7fffffff, 0x00020000), vrs = __builtin_amdgcn_make_buffer_rsrc((void*)Vh, 0, 0x7fffffff, 0x00020000);
#define DMA2(t, KB_, VB_) do { const int ko_ = (t) * (KVBLK * ldk * 2), vo_ = (t) * (KVBLK * ldv * 2); \
    _Pragma("unroll") for (int _i = 0; _i < NK; ++_i) __builtin_amdgcn_raw_ptr_buffer_load_lds(krs, (LAS void*)(K_lds + (KB_) + (_i * 8 + wid) * 1024), 16, kgo[_i], ko_, 0, 0); \
    _Pragma("unroll") for (int _i = 0; _i < 2; ++_i) __builtin_amdgcn_raw_ptr_buffer_load_lds(vrs, (LAS void*)(V_lds + (VB_) + (_i * 8 + wid) * 1024), 16, vgo[_i], vo_, 0, 0); } while (0)
#define PK4(P, BASE, OUT) do { if constexpr (KPERM) { u32x4 w = {cvt_pk_bf16(P[BASE + 0], P[BASE + 1]), cvt_pk_bf16(P[BASE + 2], P[BASE + 3]), cvt_pk_bf16(P[BASE + 4], P[BASE + 5]), cvt_pk_bf16(P[BASE + 6], P[BASE + 7])}; \
        OUT = *reinterpret_cast<bf16x8*>(&w); } else { unsigned a0 = cvt_pk_bf16(P[BASE + 0], P[BASE + 1]), a1 = cvt_pk_bf16(P[BASE + 2], P[BASE + 3]), b0_ = cvt_pk_bf16(P[BASE + 4], P[BASE + 5]), b1_ = cvt_pk_bf16(P[BASE + 6], P[BASE + 7]); \
        auto r0 = __builtin_amdgcn_permlane32_swap(a0, b0_, false, false); auto r1 = __builtin_amdgcn_permlane32_swap(a1, b1_, false, false); \
        u32x4 w = {r0[0], r1[0], r0[1], r1[1]}; OUT = *reinterpret_cast<bf16x8*>(&w); } } while (0)
#define TILEC(KB_, VB_, t, QKB, BANDTILE) do { \
        f32x16 p0, p1; \
        if constexpr (DQK == 192) qkt192n<QKB>(p0, p1, kb4, qr, nm); else \
        { const LAS unsigned char* Ks = K_lds + (KB_); \
          _Pragma("unroll") for (int d0 = 0; d0 < DQK / 16; ++d0) { const int c = d0 * 2 + hi; \
              const bf16x8 b0 = *(const LAS bf16x8*)(Ks + koff<DQK>(r32, c)); const bf16x8 b1 = *(const LAS bf16x8*)(Ks + koff<DQK>(32 + r32, c)); \
              p0 = __builtin_amdgcn_mfma_f32_32x32x16_bf16(b0, qr[d0], d0 == 0 ? nm : p0, 0, 0, 0); p1 = __builtin_amdgcn_mfma_f32_32x32x16_bf16(b1, qr[d0], d0 == 0 ? nm : p1, 0, 0, 0); } } \
        if constexpr (BIAS && BANDTILE) { const int relb = (t) * KVBLK - qabs + 128; \
            _Pragma("unroll") for (int r = 0; r < 16; ++r) { int i0 = relb + (KPERM ? 16 * (r >> 3) + 8 * hi + (r & 7) : crow(r, hi)), i1 = i0 + 32; i0 = min(max(i0, 0), 256); i1 = min(max(i1, 0), 256); p0[r] += tbl[i0]; p1[r] += tbl[i1]; } } \
        _Pragma("unroll") for (int r = 0; r < 16; ++r) { p0[r] = __builtin_amdgcn_exp2f(p0[r]); p1[r] = __builtin_amdgcn_exp2f(p1[r]); } \
        float ps = 0; \
        _Pragma("unroll") for (int r = 0; r < 16; ++r) ps += p0[r]; \
        _Pragma("unroll") for (int r = 0; r < 16; ++r) ps += p1[r]; \
        if constexpr (!KPERM) { auto rr = __builtin_amdgcn_permlane32_swap(__float_as_uint(ps), __float_as_uint(ps), false, false); ps = __uint_as_float(rr[0]) + __uint_as_float(rr[1]); } \
        l_reg += ps; \
        bf16x8 pa0, pa1, pa2, pa3; PK4(p0, 0, pa0); PK4(p0, 8, pa1); PK4(p1, 0, pa2); PK4(p1, 8, pa3); \
        pv_d0(o, vb0 + (VB_), pa0, pa1, pa2, pa3); } while (0)
#define TILE3(B, t) do { if ((t) + 2 < NT) DMA2((t) + 2, (((B) + 2) % 3) * SHM_K, (((B) + 2) % 3) * SHM_V); \
        TILEC((B) * SHM_K, (B) * SHM_V, t, B, false); \
        if ((t) + 2 < NT) asm volatile("s_waitcnt vmcnt(5) lgkmcnt(0)\n\ts_barrier" ::: "memory"); else asm volatile("s_waitcnt vmcnt(0) lgkmcnt(0)\n\ts_barrier" ::: "memory"); } while (0)
#define TILEX(B, t, BANDTILE) do { if ((t) + 1 < NT) DMA2((t) + 1, ((B) ^ 1) * 8192, ((B) ^ 1) * 16384); \
        TILEC((B) * 8192, (B) * 16384, t, 0, BANDTILE); \
        asm volatile("s_waitcnt vmcnt(0)" ::: "memory"); __syncthreads(); } while (0)
#define SETNMC(cbv) do { const float nv_ = nm_ref + (cbv); _Pragma("unroll") for (int r = 0; r < 16; ++r) nm[r] = nv_; } while (0)
    static_assert(RING == 2 || NK + 2 == 5, "counted wait assumes 5 loads per thread per tile");
    if constexpr (RING == 3) {
        DMA2(0, 0, 0); DMA2(1, SHM_K, SHM_V); asm volatile("s_waitcnt vmcnt(0) lgkmcnt(0)\n\ts_barrier" ::: "memory");
        for (int j = 0; j + 2 < NT; j += 3) { TILE3(0, j); TILE3(1, j + 1); TILE3(2, j + 2); }
        static_assert((NT - 1) % 3 == 0, "tail tile must map to buffer 0");
        TILE3(0, NT - 1);
    } else {
        DMA2(0, 0, 0); asm volatile("s_waitcnt vmcnt(0)" ::: "memory"); __syncthreads();
        int t = 0;
        if constexpr (BIAS) {
            const int nL = q0 >= 191 ? (q0 - 191) / KVBLK + 1 : 0, tR = (q0 + 383 + KVBLK - 1) / KVBLK;
            const int a = (nL / 2) * 2; int be = ((tR + 1) / 2) * 2; if (be > NT) be = NT;
            SETNMC(cb_lo);
            for (; t < a; t += 2) { TILEX(0, t, false); TILEX(1, t + 1, false); }
            SETNMC(0.f);
            for (; t < be; t += 2) { TILEX(0, t, true); TILEX(1, t + 1, true); }
            SETNMC(cb_hi);
        }
        for (; t < NT; t += 2) { TILEX(0, t, false); TILEX(1, t + 1, false); }
    }
#undef TILEC
#undef TILE3
#undef TILEX
#undef SETNMC
#undef PK4
    if constexpr (KPERM) { auto rr = __builtin_amdgcn_permlane32_swap(__float_as_uint(l_reg), __float_as_uint(l_reg), false, false); l_reg = __uint_as_float(rr[0]) + __uint_as_float(rr[1]); }
    if (hi == 0) li_l[r32] = l_reg; asm volatile("s_waitcnt lgkmcnt(0)" ::: "memory");
#pragma unroll
    for (int r = 0; r < 16; ++r) { const float rl = __builtin_amdgcn_rcpf(li_l[crow(r, hi)]);
#pragma unroll
        for (int d = 0; d < 4; ++d) o[d][r] *= rl; }
#undef DMA2
}
}

__device__ __forceinline__ int t5_bucket(int rel) {
    const int n = rel < 0 ? -rel : rel; int b;
    if (n < 8) b = n; else if (n < 12) b = 8; else if (n < 16) b = 9; else if (n < 23) b = 10; else if (n < 32) b = 11; else if (n < 46) b = 12; else if (n < 64) b = 13; else if (n < 91) b = 14; else b = 15;
    return (rel > 0 ? 16 : 0) + b;
}
template <int KIND> __device__ __forceinline__ int dst_row(int n) {
    if constexpr (KIND == 1) { if (n < 3840) return n; const int d = n - 3840; return 3840 + (d < 32 ? 2 * d : 2 * (d - 32) + 1); }
    else if constexpr (KIND == 2) { const int h = n / 192, w = n - h * 192; if (w < 128) return n; const int d = w - 128; return h * 192 + 128 + (d < 32 ? 2 * d : 2 * (d - 32) + 1); }
    else if constexpr (KIND == 3) return 256 * (n >> 7) + (n & 127);
    else if constexpr (KIND == 4) return 256 * (n >> 7) + 128 + (n & 127);
    else return n;
}
template <int KIND>
__device__ __forceinline__ void transpose_item(const float* __restrict__ W, int K, int N, const float* __restrict__ g, bf16_t* __restrict__ WT, LAS float* scr, int item, int lane) {
    const int nblk = N / 32, kb = item / nblk, nb = item - kb * nblk, k0 = 64 * kb, n0 = 32 * nb;
#pragma unroll 8
    for (int i = 0; i < 32; ++i) { const int kk = 2 * i + (lane >> 5); float v = W[(size_t)(k0 + kk) * N + n0 + (lane & 31)]; if (g) v *= g[k0 + kk]; scr[kk * 33 + (lane & 31)] = v; }
    LDS_WAIT(); asm volatile("" ::: "memory");
    const int c = lane & 7;
#pragma unroll
    for (int j = 0; j < 4; ++j) { const int n = (lane >> 3) + 8 * j; const LAS float* s = scr + (8 * c) * 33 + n;
        u32x4 o; o.x = cvt_pk_bf16(s[0 * 33], s[1 * 33]); o.y = cvt_pk_bf16(s[2 * 33], s[3 * 33]); o.z = cvt_pk_bf16(s[4 * 33], s[5 * 33]); o.w = cvt_pk_bf16(s[6 * 33], s[7 * 33]);
        *(u32x4*)(WT + (size_t)dst_row<KIND>(n0 + n) * K + k0 + 8 * c) = o; }
    LDS_WAIT(); asm volatile("" ::: "memory");
}
__device__ __forceinline__ void rms_row_bf16(const float* __restrict__ xrow, const float* __restrict__ g, bf16_t* __restrict__ orow, int lane) {
    const f32x4* xr = (const f32x4*)xrow + lane; const f32x4* gr = (const f32x4*)g + lane;
    f32x4 v[8]; float s = 0.f;
#pragma unroll
    for (int j = 0; j < 8; ++j) { v[j] = xr[64 * j]; s += (v[j].x * v[j].x + v[j].y * v[j].y) + (v[j].z * v[j].z + v[j].w * v[j].w); }
    const float rstd = rsqrtf(wave_sum(s) * (1.f / DM) + EPS);
    u32x2* o8 = (u32x2*)orow + lane;
#pragma unroll
    for (int j = 0; j < 8; ++j) { const f32x4 gg = gr[64 * j]; u32x2 w; w.x = cvt_pk_bf16(v[j].x * rstd * gg.x, v[j].y * rstd * gg.y); w.y = cvt_pk_bf16(v[j].z * rstd * gg.z, v[j].w * rstd * gg.w); o8[64 * j] = w; }
}
__device__ __forceinline__ void rms_row_f32(float* xrow, const float* __restrict__ g, int lane) {
    f32x4* xr = (f32x4*)xrow + lane; const f32x4* gr = (const f32x4*)g + lane;
    f32x4 v[8]; float s = 0.f;
#pragma unroll
    for (int j = 0; j < 8; ++j) { v[j] = xr[64 * j]; s += (v[j].x * v[j].x + v[j].y * v[j].y) + (v[j].z * v[j].z + v[j].w * v[j].w); }
    const float rstd = rsqrtf(wave_sum(s) * (1.f / DM) + EPS);
#pragma unroll
    for (int j = 0; j < 8; ++j) xr[64 * j] = v[j] * rstd * gr[64 * j];
}

#define XB_TMO      128
#define XB_XCNT(j)  (256  + 64 * (j))
#define XB_XSUB(j)  (1280 + 64 * (j))
#define XB_XGEN(j)  (2304 + 64 * (j))
#define XB_TOP      3328
#define XB_TOPGEN   3392
#define XCD_BAR_WORDS 3456
#define XB_SPIN_CAP (1u << 20)

__device__ __forceinline__ unsigned xb_ld(unsigned* p)              { return __hip_atomic_load(p, __ATOMIC_RELAXED, __HIP_MEMORY_SCOPE_AGENT); }
__device__ __forceinline__ unsigned xb_add(unsigned* p, unsigned v) { return __hip_atomic_fetch_add(p, v, __ATOMIC_RELAXED, __HIP_MEMORY_SCOPE_AGENT); }
__device__ __forceinline__ unsigned xb_xcc_id() { return (unsigned)__builtin_amdgcn_s_getreg((3 << 11) | 20) & 0xFu; }
#define XB_SPIN(cond, bar) do { unsigned _sp = 0; while (cond) { __builtin_amdgcn_s_sleep(1); \
    if ((++_sp & 255u) == 0u) { if (xb_ld(&(bar)[XB_TMO])) break; if (_sp > XB_SPIN_CAP) { atomicAdd(&(bar)[XB_TMO], 1u); break; } } } } while (0)

struct XcdBarrier {
    unsigned* bar; unsigned x;
    volatile LAS unsigned* st;
};

__device__ __forceinline__ XcdBarrier xcd_barrier_post(unsigned* bar, volatile LAS unsigned* st) {
    XcdBarrier b; b.bar = bar; b.x = xb_xcc_id(); b.st = st;
    if (threadIdx.x == 0) (void)xb_add(&bar[XB_XCNT(b.x)], 1u);
    return b;
}
__device__ __forceinline__ void xcd_barrier_complete(unsigned* bar, unsigned x, unsigned& nloc, unsigned& nx) {
    const unsigned G = gridDim.x * gridDim.y * gridDim.z;
    unsigned sum, cnt, mine, sp = 0u;
    for (;;) {
        sum = 0u; cnt = 0u; mine = 0u;
#pragma unroll
        for (unsigned j = 0; j < 16; ++j) { const unsigned c = xb_ld(&bar[XB_XCNT(j)]); sum += c; cnt += (c > 0u) ? 1u : 0u; mine = (j == x) ? c : mine; }
        if (sum == G) break;
        __builtin_amdgcn_s_sleep(1);
        if ((++sp & 255u) == 0u) { if (xb_ld(&bar[XB_TMO])) break; if (sp > XB_SPIN_CAP) { atomicAdd(&bar[XB_TMO], 1u); break; } }
    }
    nloc = mine > 0u ? mine : 1u; nx = cnt > 0u ? cnt : 1u;
}

__device__ __forceinline__ void xcd_barrier(const XcdBarrier& b) {
    asm volatile("s_waitcnt vmcnt(0)" ::: "memory");
    __syncthreads();
    if (threadIdx.x == 0) {
        unsigned* bar = b.bar;
        __builtin_amdgcn_s_waitcnt(0);
        unsigned nloc = b.st[0], nx = b.st[1];
        if (nloc == 0u) { xcd_barrier_complete(bar, b.x, nloc, nx); b.st[0] = nloc; b.st[1] = nx; }
        const unsigned old = xb_add(&bar[XB_XSUB(b.x)], 1u);
        const unsigned gen = old / nloc;
        if (old + 1u == (gen + 1u) * nloc) {
            __builtin_amdgcn_fence(__ATOMIC_RELEASE, "agent");
            asm volatile("s_waitcnt vmcnt(0)" ::: "memory");
            const unsigned og = xb_add(&bar[XB_TOP], 1u);
            const unsigned tg = og / nx;
            if (og + 1u == (tg + 1u) * nx) xb_add(&bar[XB_TOPGEN], 1u);
            else XB_SPIN(xb_ld(&bar[XB_TOPGEN]) == tg, bar);
            __builtin_amdgcn_fence(__ATOMIC_ACQUIRE, "agent");
            xb_add(&bar[XB_XGEN(b.x)], 1u);
            asm volatile("s_waitcnt vmcnt(0)" ::: "memory");
        } else {
            XB_SPIN(xb_ld(&bar[XB_XGEN(b.x)]) == gen, bar);
            __builtin_amdgcn_fence(__ATOMIC_ACQUIRE, "agent");
            asm volatile("s_waitcnt vmcnt(0)" ::: "memory");
        }
    }
    __syncthreads();
}
constexpr int LDS_BYTES = 147456;
struct Args { const float* in[19]; float* out; unsigned char* ws; int ph_lo, ph_hi; };

__global__ void __launch_bounds__(512, 2) fwd_mega(Args args) {
    extern __shared__ __attribute__((aligned(16))) unsigned char lds_raw[];
    LAS unsigned char* lds = (LAS unsigned char*)lds_raw;
    cg::grid_group grid = cg::this_grid();
    const int tid = threadIdx.x, lane = tid & 63, wave = __builtin_amdgcn_readfirstlane(tid >> 6);
    const int G = gridDim.x, bx = blockIdx.x;
    { volatile LAS unsigned* st0_ = (volatile LAS unsigned*)(lds + LDS_BYTES - 16); if (tid < 2) st0_[tid] = 0u; }
    __syncthreads();
    const XcdBarrier xbar = xcd_barrier_post((unsigned*)(args.ws + WS_BAR), (volatile LAS unsigned*)(lds + LDS_BYTES - 16));
    unsigned char* ws = args.ws;
    const float* x = args.in[0];
    bf16_t* Wt_uq = (bf16_t*)(ws + WS_WUQ); bf16_t* Wt_ukv = (bf16_t*)(ws + WS_WUKV); bf16_t* Wt_in = (bf16_t*)(ws + WS_WIN); bf16_t* Wt_out = (bf16_t*)(ws + WS_WOUT);
    bf16_t* Wt_gu = (bf16_t*)(ws + WS_WGU); bf16_t* Wt_dn = (bf16_t*)(ws + WS_WDN);
    bf16_t* HB = (bf16_t*)(ws + WS_HB); float* X1 = (float*)(ws + WS_X1); float* O1 = (float*)(ws + WS_O1);
    bf16_t* CQ = (bf16_t*)(ws + WS_CQ); bf16_t* CKV = (bf16_t*)(ws + WS_CKV); bf16_t* VB = (bf16_t*)(ws + WS_VB);
    bf16_t* QA = (bf16_t*)(ws + WS_QA); bf16_t* KA = (bf16_t*)(ws + WS_KA); bf16_t* VA = (bf16_t*)(ws + WS_VA); bf16_t* QB = (bf16_t*)(ws + WS_QB); bf16_t* KB = (bf16_t*)(ws + WS_KB);
    bf16_t* ACT = (bf16_t*)(ws + WS_ACT);
    float* LAM = (float*)(ws + WS_CTL); float* TBL = (float*)(ws + WS_TBL); float* SSQQ = (float*)(ws + WS_SSQQ); float* SSQKV = (float*)(ws + WS_SSQKV);
    float* COS = (float*)(ws + WS_COS); float* SIN = (float*)(ws + WS_SIN);
    const int lo = args.ph_lo, hi_ph = args.ph_hi;
#ifndef PH_MASK
#define PH_MASK 0x1ff
#endif
#define IN(k) (((PH_MASK >> (k)) & 1) && lo <= (k) && (k) < hi_ph)
#define GRID_BAR() xcd_barrier(xbar)
#define SEAM(k) do { if (IN(k) && IN((k) + 1)) { if ((k) == 0) grid.sync(); else GRID_BAR(); } } while (0)

    if (IN(0)) {
        LAS float* scr = (LAS float*)(lds + wave * 16384);
        const int gw = bx * 8 + wave, NGW = G * 8;
        constexpr int I_IN = (DM / 64) * (NIN / 32), I_UQ = (QLR / 64) * (NQB / 32), I_UKV = (KVLR / 64) * (NKV / 32), I_OUT = (DM / 64) * (DM / 32), I_G = (DM / 64) * (DFF / 32), I_DN = (DFF / 64) * (DM / 32);
        constexpr int NITEMS = I_IN + I_UQ + I_UKV + I_OUT + 2 * I_G + I_DN;
        for (int it = gw; it < NITEMS; it += NGW) {
            int r = it;
            if (r < I_IN) { transpose_item<1>(args.in[2], DM, NIN, nullptr, Wt_in, scr, r, lane); continue; } r -= I_IN;
            if (r < I_UQ) { transpose_item<2>(args.in[4], QLR, NQB, args.in[3], Wt_uq, scr, r, lane); continue; } r -= I_UQ;
            if (r < I_UKV) { transpose_item<0>(args.in[6], KVLR, NKV, args.in[5], Wt_ukv, scr, r, lane); continue; } r -= I_UKV;
            if (r < I_OUT) { transpose_item<0>(args.in[13], DM, DM, nullptr, Wt_out, scr, r, lane); continue; } r -= I_OUT;
            if (r < I_G) { transpose_item<3>(args.in[15], DM, DFF, nullptr, Wt_gu, scr, r, lane); continue; } r -= I_G;
            if (r < I_G) { transpose_item<4>(args.in[16], DM, DFF, nullptr, Wt_gu, scr, r, lane); continue; } r -= I_G;
            transpose_item<0>(args.in[17], DFF, DM, nullptr, Wt_dn, scr, r, lane);
        }
        for (int m = gw; m < S; m += NGW) rms_row_bf16(x + (size_t)m * DM, args.in[1], HB + (size_t)m * DM, lane);
        const int gt = bx * 512 + tid, NGT = G * 512;
        for (int i = gt; i < (NINP - NIN) * DM / 8; i += NGT) ((u32x4*)(Wt_in + (size_t)NIN * DM))[i] = (u32x4){0u, 0u, 0u, 0u};
        for (int i = gt; i < S; i += NGT) { SSQQ[i] = 0.f; SSQKV[i] = 0.f; }
        for (int i = gt; i < S * 32; i += NGT) { const int pos = i >> 5, f = i & 31; const float inv = powf(10000.f, -(float)f / 32.f); const float ang = (float)pos * inv; COS[i] = cosf(ang); SIN[i] = sinf(ang); }
        if (gt < 32) ((float*)(ws + WS_KMXA))[gt] = 0.f; else if (gt < 64) ((float*)(ws + WS_KMXB))[gt - 32] = 0.f; else if (gt < 66) ((float*)(ws + WS_KMXR))[gt - 64] = 0.f;
        else if (gt < 74) { const int h = gt - 66; float mx = -1e30f; for (int bk = 0; bk < 32; ++bk) mx = fmaxf(mx, args.in[12][bk * 8 + h]); ((float*)(ws + WS_TBLMAX))[h] = mx * LOG2E; }
        for (int i = gt; i < 8 * 257; i += NGT) { const int h = i / 257, idx = i - h * 257; TBL[i] = args.in[12][t5_bucket(idx - 128) * 8 + h] * LOG2E; }
        if (bx == 0 && wave == 0) { const float s1 = wave_sum(args.in[7][lane] * args.in[8][lane]), s2 = wave_sum(args.in[9][lane] * args.in[10][lane]);
            if (lane == 0) LAM[0] = expf(s1) - expf(s2) + 0.2f; }
        __syncthreads();
    }
    SEAM(0);
    if (IN(1)) {
        pg8::Gemm g{HB, Wt_in, S, NINP, DM}; pg8::StaticOrder So; So.init(S, NINP, G, bx);
        EpiIn E{ws};
        pg8::gemm_phase<EpiIn, pg8::StaticOrder, true, true>(lds, g, So, E);
    }
    SEAM(1);
    if (IN(2)) {
        { pg8::Gemm g{CQ, Wt_uq, S, NQB, QLR}; pg8::StaticOrder So; So.init(S, NQB, G, bx); EpiQB E{QB, SSQQ, COS, SIN};
          pg8::gemm_phase<EpiQB, pg8::StaticOrder, true, true>(lds, g, So, E); }
        { pg8::Gemm g{CKV, Wt_ukv, S, NKV, KVLR}; pg8::StaticOrder So; So.init(S, NKV, G, bx); EpiKV E{KB, VB, SSQKV, (unsigned*)(ws + WS_KMXB)};
          pg8::gemm_phase<EpiKV, pg8::StaticOrder, true, true>(lds, g, So, E); }
    }
    SEAM(2);
    if (IN(3)) {
        const int r32 = lane & 31, hi = lane >> 5;
        const float lam = __uint_as_float(__builtin_amdgcn_readfirstlane(__float_as_uint(LAM[0])));
        LAS float* tbl_l = (LAS float*)(lds + att::OFF_TBL);
        const float* KMXA = (const float*)(ws + WS_KMXA); const float* KMXB = (const float*)(ws + WS_KMXB); const float* KMXR = (const float*)(ws + WS_KMXR); const float* TBLMAX = (const float*)(ws + WS_TBLMAX);
        float* OXb = O1 + (size_t)bx * (2 * 256 * 128);
#ifndef REPA
#define REPA 1
#endif
#ifndef REPB
#define REPB 1
#endif
        for (int rep = 0; rep < REPA; ++rep)
        for (int it = 0; ; ++it) {
            const int u = bx + (it >> 1) * G, mp = it & 1; if (u >= 512) break;
            const int h = u & 7, q0 = (u >> 3) * 256;
            for (int i = tid; i < 257; i += 512) tbl_l[i] = TBL[h * 257 + i];
            const float cb_lo = __uint_as_float(__builtin_amdgcn_readfirstlane(__float_as_uint(TBL[h * 257]))), cb_hi = __uint_as_float(__builtin_amdgcn_readfirstlane(__float_as_uint(TBL[h * 257 + 256])));
            f32x16 o[4];
            const float kmx = sqrtf(__uint_as_float(__builtin_amdgcn_readfirstlane(__float_as_uint(KMXA[(h * 2 + mp) * 2] + KMXA[(h * 2 + mp) * 2 + 1])))), bmx = __uint_as_float(__builtin_amdgcn_readfirstlane(__float_as_uint(TBLMAX[h])));
            att::attn_f<64, true, 1024, 1024, 1024>(QA + (size_t)q0 * 1024 + h * 128 + mp * 64, KA + h * 128 + mp * 64, VA + h * 128, lds, q0, cb_lo, cb_hi, kmx, bmx, o);
            { float* OX = OXb + mp * (256 * 128) + (wave * 32) * 128 + r32;
#pragma unroll
                for (int r = 0; r < 16; ++r)
#pragma unroll
                    for (int d = 0; d < 4; ++d) OX[att::crow(r, hi) * 128 + d * 32] = o[d][r]; }
            if (mp == 1) {
                __syncthreads();
                const f32x2 gs = *(const f32x2*)(args.in[11] + 2 * lane);
                for (int rr = wave; rr < 256; rr += 32) {
                    float v0[4], v1[4], ss[4];
#pragma unroll
                    for (int q = 0; q < 4; ++q) { const int row = rr + 8 * q;
                        const f32x2 a = *(const f32x2*)(OXb + row * 128 + 2 * lane), b = *(const f32x2*)(OXb + 256 * 128 + row * 128 + 2 * lane);
                        v0[q] = a.x - lam * b.x; v1[q] = a.y - lam * b.y; ss[q] = v0[q] * v0[q] + v1[q] * v1[q]; }
#pragma unroll
                    for (int o_ = 1; o_ < 64; o_ <<= 1)
#pragma unroll
                        for (int q = 0; q < 4; ++q) ss[q] += __shfl_xor(ss[q], o_);
#pragma unroll
                    for (int q = 0; q < 4; ++q) { const float rstd = rsqrtf(ss[q] * (1.f / 128.f) + EPS) * 0.8f;
                        *(unsigned*)(HB + (size_t)(q0 + rr + 8 * q) * DM + h * 128 + 2 * lane) = cvt_pk_bf16(v0[q] * rstd * gs.x, v1[q] * rstd * gs.y); }
                }
                __syncthreads();
            }
        }
        for (int rep = 0; rep < REPB; ++rep)
        for (int u = bx; u < 512; u += G) {
            const int h = u & 7, q0 = (u >> 3) * 256;
            f32x16 o[4];
            const float kmx = sqrtf(__uint_as_float(__builtin_amdgcn_readfirstlane(__float_as_uint((KMXB[h * 4] + KMXB[h * 4 + 1]) + (KMXB[h * 4 + 2] + KMXB[h * 4 + 3]) + (KMXR[0] + KMXR[1])))));
            att::attn_f<192, false, NQB, NQB, 1024>(QB + (size_t)q0 * NQB + h * 192, KB + h * 192, VB + h * 128, lds, q0, 0.f, 0.f, kmx, 0.f, o);
            bf16_t* mix = HB + (size_t)(q0 + wave * 32) * DM + 1024 + h * 128 + r32;
#pragma unroll
            for (int r = 0; r < 16; ++r)
#pragma unroll
                for (int d = 0; d < 4; ++d) mix[(size_t)att::crow(r, hi) * DM + d * 32] = (bf16_t)(cvt_pk_bf16(o[d][r], 0.f) & 0xffffu);
        }
        __syncthreads();
    }
    SEAM(3);
    if (IN(4)) {
        pg8::Gemm g{HB, Wt_out, S, DM, DM}; pg8::StaticOrder So; So.init(S, DM, G, bx); EpiRes E{x, X1};
        pg8::gemm_phase<EpiRes, pg8::StaticOrder, true, true>(lds, g, So, E);
    }
    SEAM(4);
    if (IN(5)) {
        const int gw = bx * 8 + wave, NGW = G * 8;
        for (int m = gw; m < S; m += NGW) rms_row_bf16(X1 + (size_t)m * DM, args.in[14], HB + (size_t)m * DM, lane);
    }
    SEAM(5);
    if (IN(6)) {
        pg8::Gemm g{HB, Wt_gu, S, NGU, DM}; pg8::StaticOrder So; So.init(S, NGU, G, bx); EpiGU E{ACT};
#ifndef REP6
#define REP6 1
#endif
        for (int rep = 0; rep < REP6; ++rep)
        pg8::gemm_phase<EpiGU, pg8::StaticOrder, true, true>(lds, g, So, E);
    }
    SEAM(6);
    if (IN(7)) {
        pg8::Gemm g{ACT, Wt_dn, S, DM, DFF}; pg8::StaticOrder So; So.init(S, DM, G, bx); EpiRes E{X1, args.out};
        pg8::gemm_phase<EpiRes, pg8::StaticOrder, true, true>(lds, g, So, E);
    }
    SEAM(7);
    if (IN(8)) {
        const int gw = bx * 8 + wave, NGW = G * 8;
        for (int m = gw; m < S; m += NGW) rms_row_f32(args.out + (size_t)m * DM, args.in[18], lane);
    }
#undef IN
#undef SEAM
}

extern "C" void kernel_launch(void* const* d_in, const int* in_sizes, int n_in, void* d_out, int out_size, void* d_ws, size_t ws_size, hipStream_t stream) {
    static int grid = 0;
    if (grid == 0) {
        if (n_in != 19 || in_sizes[0] != S * DM || out_size != S * DM || ws_size < WS_END) {
            fprintf(stderr, "kernel_launch: shape/workspace mismatch: n_in %d in0 %d out %d ws %zu (need %zu)\n", n_in, n_in > 0 ? in_sizes[0] : -1, out_size, ws_size, (size_t)WS_END); grid = -1; return; }
        int dev = 0, cus = 0, per_cu = 0;
        (void)hipGetDevice(&dev); (void)hipDeviceGetAttribute(&cus, hipDeviceAttributeMultiprocessorCount, dev);
        if (hipFuncSetAttribute((const void*)fwd_mega, hipFuncAttributeMaxDynamicSharedMemorySize, LDS_BYTES) != hipSuccess) { fprintf(stderr, "kernel_launch: hipFuncSetAttribute failed\n"); grid = -1; return; }
        if (hipOccupancyMaxActiveBlocksPerMultiprocessor(&per_cu, (const void*)fwd_mega, 512, LDS_BYTES) != hipSuccess || per_cu < 1) { fprintf(stderr, "kernel_launch: occupancy query says %d\n", per_cu); per_cu = 1; }
        (void)hipGetLastError();
        grid = cus < 256 ? cus : 256;
    }
    if (grid < 0) return;
    Args a{};
    for (int i = 0; i < 19; ++i) a.in[i] = (const float*)d_in[i];
    a.out = (float*)d_out; a.ws = (unsigned char*)d_ws;
#if MK_N_LAUNCHES == 1
    a.ph_lo = 0; a.ph_hi = NPHASE;
    void* kargs[] = {&a};
    (void)hipMemsetAsync((char*)d_ws + WS_BAR, 0, 16384, stream);
    hipError_t e = hipLaunchCooperativeKernel((const void*)fwd_mega, dim3(grid), dim3(512), kargs, LDS_BYTES, stream);
    if (e != hipSuccess) fprintf(stderr, "kernel_launch: cooperative launch failed: %s (grid %d)\n", hipGetErrorString(e), grid);
#else
    for (int p = 0; p < NPHASE; ++p) { a.ph_lo = p; a.ph_hi = p + 1; hipLaunchKernelGGL(fwd_mega, dim3(grid), dim3(512), LDS_BYTES, stream, a); }
#endif
}
```
